# Optimizing an MI355X kernel written in HIP

```python
import functools
import jax, jax.numpy as jnp
from jax import lax
import numpy as np

D_MODEL = 2048
BATCH = 8
SEQ = 2048
DEPTH = 2

GRID_W = 64
CTX_LEN = 256
HEAD_DIM = 128
N_MIX_HEADS = D_MODEL // HEAD_DIM
ATT_Q_HEADS = N_MIX_HEADS // 2
ATT_KV_HEADS = ATT_Q_HEADS // 4
RET_HEADS = N_MIX_HEADS // 4
RET_DIM = HEAD_DIM
GLA_HEADS = N_MIX_HEADS // 4
GLA_DK = HEAD_DIM // 2
GLA_DV = HEAD_DIM
GLA_GATE_RANK = 16
GLA_TAU = 16.0
D_FF = 5632
ROPE_THETA = 10000.0
Q_BLOCK = 128
RET_CHUNK = 128
GLA_CHUNK = 64
N_MOD = 6
EPS = 1e-6
ATT_W = ATT_Q_HEADS * HEAD_DIM
ATT_KV_W = ATT_KV_HEADS * HEAD_DIM
RET_W = RET_HEADS * RET_DIM
GLA_K_W = GLA_HEADS * GLA_DK
GLA_V_W = GLA_HEADS * GLA_DV
IN_SPLITS = (ATT_W, ATT_KV_W, ATT_KV_W, RET_W, RET_W, RET_W, RET_W, GLA_K_W, GLA_K_W, GLA_V_W, GLA_V_W, 2 * GLA_GATE_RANK)
N_IN = ATT_W + 2 * ATT_KV_W + 4 * RET_W + 2 * GLA_K_W + 2 * GLA_V_W + 2 * GLA_GATE_RANK

kernel_name = "hymba_style_diffusion_hybrid_attn_retnet_gla"


def rms_norm(x, g):
    xf = x.astype(jnp.float32)
    y = xf * lax.rsqrt(jnp.mean(xf * xf, axis=-1, keepdims=True) + EPS)
    return (y * g.astype(jnp.float32)).astype(x.dtype)


def modulate(h, shift, scale):
    return h * (1 + scale) + shift


def split_heads(t, n_heads):
    B, L, _ = t.shape
    return t.reshape(B, L, n_heads, -1).transpose(0, 2, 1, 3)


def merge_heads(t):
    B, H, L, d = t.shape
    return t.transpose(0, 2, 1, 3).reshape(B, L, H * d)


def axial_rope(n_tokens):
    rows = n_tokens // GRID_W
    row = jnp.repeat(jnp.arange(rows, dtype=jnp.float32), GRID_W)
    col = jnp.tile(jnp.arange(GRID_W, dtype=jnp.float32), rows)
    n_freq = HEAD_DIM // 4
    inv_freq = ROPE_THETA ** (-jnp.arange(n_freq, dtype=jnp.float32) / n_freq)
    ang = jnp.concatenate([row[:, None] * inv_freq, col[:, None] * inv_freq], axis=-1)
    return jnp.cos(ang), jnp.sin(ang)


def apply_rope(t, cos, sin):
    half = t.shape[-1] // 2
    t1, t2 = t[..., :half], t[..., half:]
    cos = cos.astype(t.dtype)
    sin = sin.astype(t.dtype)
    return jnp.concatenate([t1 * cos - t2 * sin, t1 * sin + t2 * cos], axis=-1)


def project_inputs(h, w_in, q_norm_g, k_norm_g, gla_gate_up, gla_gate_b, rope):
    B, L, _ = h.shape
    f32 = jnp.float32
    z = h @ w_in
    cuts = np.cumsum(IN_SPLITS)[:-1].tolist()
    aq, ak, av, rq, rk, rv, rg, gq, gk, gv, gr, ga = jnp.split(z, cuts, axis=-1)
    aq = rms_norm(split_heads(aq, ATT_Q_HEADS), q_norm_g)
    ak = rms_norm(split_heads(ak, ATT_KV_HEADS), k_norm_g)
    rq = split_heads(rq, RET_HEADS)
    rk = split_heads(rk, RET_HEADS) * (RET_DIM ** -0.5)
    if rope is not None:
        cos, sin = rope
        aq, ak, rq, rk = (apply_rope(t, cos, sin) for t in (aq, ak, rq, rk))
    logit = jnp.einsum('blnr,nrk->nblk', ga.reshape(B, L, 2, GLA_GATE_RANK), gla_gate_up) + gla_gate_b[:, None, None, :]
    log_a = jax.nn.log_sigmoid(logit.astype(f32)) / GLA_TAU
    return dict(
        aq=aq, ak=ak, av=split_heads(av, ATT_KV_HEADS),
        rq=rq.astype(f32), rk=rk.astype(f32), rv=split_heads(rv, RET_HEADS).astype(f32), rg=rg,
        gq=(split_heads(gq, GLA_HEADS) * (GLA_DK ** -0.5)).astype(f32),
        gk=split_heads(gk, GLA_HEADS).astype(f32), gv=split_heads(gv, GLA_HEADS).astype(f32), gr=gr,
        la_f=split_heads(log_a[0], GLA_HEADS), la_b=split_heads(log_a[1], GLA_HEADS))


def softmax_attention(q, k, v):
    B, Hq, Lq, d = q.shape
    Hkv = k.shape[1]
    G = Hq // Hkv
    nb = Lq // Q_BLOCK
    qb = q.reshape(B, Hkv, G, nb, Q_BLOCK, d).transpose(3, 0, 1, 2, 4, 5)
    scale = d ** -0.5

    def block(qi):
        s = jnp.einsum('bkgqd,bksd->bkgqs', qi, k).astype(jnp.float32) * scale
        p = jax.nn.softmax(s, axis=-1).astype(v.dtype)
        return jnp.einsum('bkgqs,bksd->bkgqd', p, v)

    o = lax.map(block, qb)
    return o.transpose(1, 2, 3, 0, 4, 5).reshape(B, Hq, Lq, d)


def retention_scan(log_g, q, k, v, s0):
    B, H, L, _ = q.shape
    C = RET_CHUNK
    n = L // C
    f32 = jnp.float32
    lg = log_g.astype(f32)[:, None]
    idx = jnp.arange(C, dtype=f32)
    rel = idx[:, None] - idx[None, :]
    causal = rel >= 0
    d_in = jnp.where(causal, jnp.exp(lg[:, :, None] * jnp.where(causal, rel, 0.0)), 0.0)
    q_dec = jnp.exp(lg * (idx + 1))[..., None]
    k_dec = jnp.exp(lg * (C - 1 - idx))[..., None]
    c_dec = jnp.exp(lg * C)[..., None]

    def chunks(t):
        return jnp.moveaxis(t.reshape(B, H, n, C, t.shape[-1]), 2, 0)

    def step(S, inp):
        qc, kc, vc = inp
        att = jnp.einsum('bhid,bhjd->bhij', qc, kc) * d_in
        o = jnp.einsum('bhij,bhjv->bhiv', att, vc) + jnp.einsum('bhid,bhdv->bhiv', qc * q_dec, S)
        S = c_dec * S + jnp.einsum('bhjd,bhjv->bhdv', kc * k_dec, vc)
        return S, o

    S, o = lax.scan(step, s0, (chunks(q), chunks(k), chunks(v)))
    return jnp.moveaxis(o, 0, 2).reshape(B, H, L, -1), S


def gla_scan(q, k, v, log_a, s0):
    B, H, L, _ = q.shape
    C = GLA_CHUNK
    n = L // C
    causal = jnp.tril(jnp.ones((C, C), dtype=bool))[:, :, None]

    def chunks(t):
        return jnp.moveaxis(t.reshape(B, H, n, C, t.shape[-1]), 2, 0)

    def step(S, inp):
        qc, kc, vc, ac = inp
        b = jnp.cumsum(ac, axis=2)
        diff = b[:, :, :, None, :] - b[:, :, None, :, :]
        dec = jnp.where(causal, jnp.exp(jnp.where(causal, diff, 0.0)), 0.0)
        att = jnp.einsum('bhid,bhjd,bhijd->bhij', qc, kc, dec)
        o = jnp.einsum('bhij,bhjv->bhiv', att, vc) + jnp.einsum('bhid,bhdv->bhiv', qc * jnp.exp(b), S)
        b_end = b[:, :, -1:, :]
        S = jnp.exp(b_end[:, :, 0, :, None]) * S + jnp.einsum('bhjd,bhjv->bhdv', kc * jnp.exp(b_end - b), vc)
        return S, o

    S, o = lax.scan(step, s0, (chunks(q), chunks(k), chunks(v), chunks(log_a)))
    return jnp.moveaxis(o, 0, 2).reshape(B, H, L, -1), S


def run_bidirectional(scan_f, scan_b, ctx_f, ctx_b, lat_f, lat_b, s0):
    flip = lambda ts: tuple(jnp.flip(t, axis=2) for t in ts)
    o_cf, s_cf = scan_f(*ctx_f, s0)
    o_cb, s_cb = scan_b(*flip(ctx_b), s0)
    o_lf, _ = scan_f(*lat_f, s_cf)
    o_lb, _ = scan_b(*flip(lat_b), s_cb)
    return o_cf + jnp.flip(o_cb, axis=2), o_lf + jnp.flip(o_lb, axis=2)


def mixer_output(o_att, o_ret, g_ret, o_gla, g_gla, ret_norm_g, gla_norm_g, w_out):
    dt = g_ret.dtype
    att = merge_heads(o_att).astype(dt)
    ret = merge_heads(rms_norm(o_ret, ret_norm_g)).astype(dt) * jax.nn.silu(g_ret)
    gla = merge_heads(rms_norm(o_gla, gla_norm_g)).astype(dt) * jax.nn.silu(g_gla)
    return jnp.concatenate([att, ret, gla], axis=-1) @ w_out


def dwconv3(u, w, b):
    up = jnp.pad(u, ((0, 0), (1, 1), (0, 0)))
    return up[:, :-2] * w[0] + up[:, 1:-1] * w[1] + up[:, 2:] * w[2] + b


def conv_glu(h, w_up, conv_w, conv_b, w_down):
    a, v = jnp.split(h @ w_up, 2, axis=-1)
    return (jax.nn.silu(dwconv3(a, conv_w, conv_b)) * v) @ w_down


def setup_inputs(seed: int = 0) -> dict:
    key = jax.random.key(seed)
    ks = jax.random.split(key, 22)
    f32 = jnp.float32

    def nrm(k, shape, scale):
        return jax.random.normal(k, shape, f32) * scale

    def gain(k, shape):
        return 1.0 + 0.02 * jax.random.normal(k, shape, f32)

    decay0 = jnp.log(1.0 - 2.0 ** (-5.0 - jnp.arange(RET_HEADS, dtype=f32)))
    return {
        "x": nrm(ks[0], (BATCH, SEQ, D_MODEL), 1.0),
        "c": nrm(ks[1], (BATCH, D_MODEL), 1.0),
        "ctx": nrm(ks[2], (BATCH, CTX_LEN, D_MODEL), 1.0),
        "c_ctx": nrm(ks[3], (D_MODEL,), 1.0),
        "ada_w": nrm(ks[4], (DEPTH, D_MODEL, N_MOD * D_MODEL), 0.5 * D_MODEL ** -0.5),
        "ada_b": nrm(ks[5], (DEPTH, N_MOD * D_MODEL), 0.01),
        "norm1_g": gain(ks[6], (DEPTH, D_MODEL)),
        "w_in": nrm(ks[7], (DEPTH, D_MODEL, N_IN), D_MODEL ** -0.5),
        "q_norm_g": gain(ks[8], (DEPTH, HEAD_DIM)),
        "k_norm_g": gain(ks[9], (DEPTH, HEAD_DIM)),
        "ret_log_decay": decay0 * (1.0 + 0.05 * jax.random.normal(ks[10], (DEPTH, 2, RET_HEADS), f32)),
        "ret_norm_g": gain(ks[11], (DEPTH, RET_DIM)),
        "gla_gate_up": nrm(ks[12], (DEPTH, 2, GLA_GATE_RANK, GLA_K_W), GLA_GATE_RANK ** -0.5),
        "gla_gate_b": nrm(ks[13], (DEPTH, 2, GLA_K_W), 0.1),
        "gla_norm_g": gain(ks[14], (DEPTH, GLA_DV)),
        "w_out": nrm(ks[15], (DEPTH, D_MODEL, D_MODEL), D_MODEL ** -0.5),
        "norm2_g": gain(ks[16], (DEPTH, D_MODEL)),
        "w_up": nrm(ks[17], (DEPTH, D_MODEL, 2 * D_FF), D_MODEL ** -0.5),
        "conv_w": nrm(ks[18], (DEPTH, 3, D_FF), 3 ** -0.5),
        "conv_b": nrm(ks[19], (DEPTH, D_FF), 0.01),
        "w_down": nrm(ks[20], (DEPTH, D_FF, D_MODEL), D_FF ** -0.5),
        "final_norm_g": gain(ks[21], (D_MODEL,)),
    }


def reference(x, c, ctx, c_ctx, ada_w, ada_b, norm1_g, w_in, q_norm_g, k_norm_g, ret_log_decay, ret_norm_g, gla_gate_up, gla_gate_b, gla_norm_g, w_out, norm2_g, w_up, conv_w, conv_b, w_down, final_norm_g):
    B, L, D = x.shape
    f32 = jnp.float32
    rope = axial_rope(L)
    s0_ret = jnp.zeros((B, RET_HEADS, RET_DIM, RET_DIM), f32)
    s0_gla = jnp.zeros((B, GLA_HEADS, GLA_DK, GLA_DV), f32)
    xc = ctx
    for l in range(DEPTH):
        last = l == DEPTH - 1
        mod = (jax.nn.silu(c) @ ada_w[l] + ada_b[l]).reshape(B, N_MOD, 1, D)
        mod_c = (jax.nn.silu(c_ctx) @ ada_w[l] + ada_b[l]).reshape(N_MOD, 1, 1, D)

        h = modulate(rms_norm(x, norm1_g[l]), mod[:, 0], mod[:, 1])
        hc = modulate(rms_norm(xc, norm1_g[l]), mod_c[0], mod_c[1])
        lat = project_inputs(h, w_in[l], q_norm_g[l], k_norm_g[l], gla_gate_up[l], gla_gate_b[l], rope)
        cx = project_inputs(hc, w_in[l], q_norm_g[l], k_norm_g[l], gla_gate_up[l], gla_gate_b[l], None)

        k_all = jnp.concatenate([cx['ak'], lat['ak']], axis=2)
        v_all = jnp.concatenate([cx['av'], lat['av']], axis=2)
        att_lat = softmax_attention(lat['aq'], k_all, v_all)

        ret_ctx, ret_lat = run_bidirectional(
            functools.partial(retention_scan, ret_log_decay[l, 0]),
            functools.partial(retention_scan, ret_log_decay[l, 1]),
            (cx['rq'], cx['rk'], cx['rv']), (cx['rq'], cx['rk'], cx['rv']),
            (lat['rq'], lat['rk'], lat['rv']), (lat['rq'], lat['rk'], lat['rv']), s0_ret)

        gla_ctx, gla_lat = run_bidirectional(
            gla_scan, gla_scan,
            (cx['gq'], cx['gk'], cx['gv'], cx['la_f']), (cx['gq'], cx['gk'], cx['gv'], cx['la_b']),
            (lat['gq'], lat['gk'], lat['gv'], lat['la_f']), (lat['gq'], lat['gk'], lat['gv'], lat['la_b']), s0_gla)

        y = mixer_output(att_lat, ret_lat, lat['rg'], gla_lat, lat['gr'], ret_norm_g[l], gla_norm_g[l], w_out[l])
        x = x + mod[:, 2] * y

        h2 = modulate(rms_norm(x, norm2_g[l]), mod[:, 3], mod[:, 4])
        x = x + mod[:, 5] * conv_glu(h2, w_up[l], conv_w[l], conv_b[l], w_down[l])

        if not last:
            att_ctx = softmax_attention(cx['aq'], cx['ak'], cx['av'])
            yc = mixer_output(att_ctx, ret_ctx, cx['rg'], gla_ctx, cx['gr'], ret_norm_g[l], gla_norm_g[l], w_out[l])
            xc = xc + mod_c[2] * yc
            hc2 = modulate(rms_norm(xc, norm2_g[l]), mod_c[3], mod_c[4])
            xc = xc + mod_c[5] * conv_glu(hc2, w_up[l], conv_w[l], conv_b[l], w_down[l])
    return rms_norm(x, final_norm_g)
```

```cpp
#include <hip/hip_runtime.h>
#include <hip/hip_bf16.h>
#include <hip/hip_cooperative_groups.h>
#include <cstdio>
#include <cstdint>
namespace cg = cooperative_groups;

#ifndef PROBE
#define PROBE 0
#endif
#define REPS(bit) (((PROBE) >> (bit)) & 1 ? 2 : 1)
typedef unsigned short bf16_t;
using bf16x8 = __attribute__((ext_vector_type(8))) short;
using s16x4  = __attribute__((ext_vector_type(4))) short;
using f32x4  = __attribute__((ext_vector_type(4))) float;
using f32x16 = __attribute__((ext_vector_type(16))) float;
using u32x4  = __attribute__((ext_vector_type(4))) unsigned;
using u32x2  = __attribute__((ext_vector_type(2))) unsigned;

constexpr int NB = 8, SEQ = 2048, CTX = 256, DM = 2048, DFF = 5632, NIN = 5152;
constexpr int RPB = SEQ + CTX;
constexpr int NROWS = NB * RPB;
constexpr int ZLD = 5376;
constexpr int NMOD = 6 * DM;
constexpr int C_AQ = 0, C_AK = 1024, C_AV = 1280, C_RQ = 1536, C_RK = 2048, C_RV = 2560, C_RG = 3072,
              C_GQ = 3584, C_GK = 3840, C_GV = 4096, C_GR = 4608, C_GA = 5120;
constexpr float EPS = 1e-6f;
constexpr int NTHR = 512;
constexpr int SHM_BYTES = 139264;

struct Params {
  const float *x, *c, *ctx, *c_ctx, *ada_w, *ada_b, *norm1_g, *w_in, *q_norm_g, *k_norm_g, *ret_log_decay, *ret_norm_g,
      *gla_gate_up, *gla_gate_b, *gla_norm_g, *w_out, *norm2_g, *w_up, *conv_w, *conv_b, *w_down, *final_norm_g;
  float* out;
  bf16_t *Wt_in, *Wt_out, *Wt_up, *Wt_down;
  float* mod;
  float* X;
  bf16_t* H;
  bf16_t* Z;
  bf16_t* U;
  bf16_t* GQt;
  bf16_t* GKt;
  float* Eend;
  bf16_t* RO;
  bf16_t* GO;
  float* HA;
  float* HB;
  unsigned* ctl;
  float* sW;
  float* sWin;
  bf16_t* Kc;
  bf16_t* Vc;
};

typedef const __attribute__((address_space(4))) Params* KP;
__device__ __forceinline__ KP relaunder(KP p) { asm volatile("" : "+s"(p)); return p; }

__device__ __forceinline__ float bf2f(bf16_t h) { return __uint_as_float((unsigned)h << 16); }
__device__ __forceinline__ bf16_t f2bf(float f) { unsigned u = __float_as_uint(f); u += 0x7fffu + ((u >> 16) & 1u); return (bf16_t)(u >> 16); }
__device__ __forceinline__ unsigned cvtpk_asm(float lo, float hi) { unsigned r; asm volatile("v_cvt_pk_bf16_f32 %0, %1, %2" : "=v"(r) : "v"(lo), "v"(hi)); return r; }
typedef __bf16 bf16v2_t __attribute__((ext_vector_type(2)));
typedef float f32v2_t __attribute__((ext_vector_type(2)));
__device__ __forceinline__ unsigned cvtpk(float lo, float hi) { const f32v2_t v = {lo, hi}; const bf16v2_t b = __builtin_convertvector(v, bf16v2_t); return __builtin_bit_cast(unsigned, b); }
template <int X> __device__ __forceinline__ float swz_xor(float v) { return __int_as_float(__builtin_amdgcn_ds_swizzle(__float_as_int(v), (X << 10) | 0x1F)); }
__device__ __forceinline__ float wave_sum(float v) {
  v += swz_xor<16>(v); v += swz_xor<8>(v); v += swz_xor<4>(v); v += swz_xor<2>(v); v += swz_xor<1>(v);
  auto rr = __builtin_amdgcn_permlane32_swap(__float_as_uint(v), __float_as_uint(v), false, false);
  return __uint_as_float(rr[0]) + __uint_as_float(rr[1]);
}
__device__ __forceinline__ int otid(int wv) { unsigned z = 0u; asm volatile("" : "+v"(z)); return (wv << 6) | (int)__builtin_amdgcn_mbcnt_hi(~0u, __builtin_amdgcn_mbcnt_lo(~0u, z)); }
__device__ __forceinline__ float silu_f(float x) { return x * __builtin_amdgcn_rcpf(1.f + __builtin_amdgcn_exp2f(-1.4426950408889634f * x)); }
__device__ __forceinline__ float fexp(float x) { return __builtin_amdgcn_exp2f(1.4426950408889634f * x); }

#define XB_TMO      128
#define XB_XCNT(j)  (256  + 64 * (j))
#define XB_XSUB(j)  (1280 + 64 * (j))
#define XB_XGEN(j)  (2304 + 64 * (j))
#define XB_TOP      3328
#define XB_TOPGEN   3392
#define XCD_BAR_WORDS 3456
#define WQ_WORD(l, x) (XCD_BAR_WORDS + 64 * ((l) * 8 + (x)))
#define SSQ_WORD (XCD_BAR_WORDS + 64 * 16)
#define CTL_WORDS (SSQ_WORD + 3 * 18432)
#define XB_SPIN_CAP (1u << 22)
#define LAS __attribute__((address_space(3)))
__device__ __forceinline__ unsigned xb_ld(unsigned* p)              { return __hip_atomic_load(p, __ATOMIC_RELAXED, __HIP_MEMORY_SCOPE_AGENT); }
__device__ __forceinline__ unsigned xb_add(unsigned* p, unsigned v) { return __hip_atomic_fetch_add(p, v, __ATOMIC_RELAXED, __HIP_MEMORY_SCOPE_AGENT); }
__device__ __forceinline__ unsigned xb_xcc_id() { return (unsigned)__builtin_amdgcn_s_getreg((3 << 11) | 20) & 0xFu; }
#define XB_SPIN(cond, bar) do { unsigned _sp = 0; while (cond) { __builtin_amdgcn_s_sleep(1); \
    if ((++_sp & 255u) == 0u) { if (xb_ld(&(bar)[XB_TMO])) break; if (_sp > XB_SPIN_CAP) { atomicAdd(&(bar)[XB_TMO], 1u); break; } } } } while (0)
struct XcdBarrier { unsigned* bar; unsigned x; volatile LAS unsigned* st; };
__device__ __forceinline__ XcdBarrier xcd_barrier_post(unsigned* bar, volatile LAS unsigned* st) {
  XcdBarrier b; b.bar = bar; b.x = xb_xcc_id(); b.st = st;
  if (threadIdx.x == 0) (void)xb_add(&bar[XB_XCNT(b.x)], 1u);
  return b;
}
__device__ __forceinline__ void xcd_barrier_complete(unsigned* bar, unsigned x, unsigned& nloc, unsigned& nx) {
  const unsigned G = gridDim.x * gridDim.y * gridDim.z;
  unsigned sum, cnt, mine, sp = 0u;
  for (;;) {
    sum = 0u; cnt = 0u; mine = 0u;
#pragma unroll
    for (unsigned j = 0; j < 16; ++j) { const unsigned c = xb_ld(&bar[XB_XCNT(j)]); sum += c; cnt += (c > 0u) ? 1u : 0u; mine = (j == x) ? c : mine; }
    if (sum == G) break;
    __builtin_amdgcn_s_sleep(1);
    if ((++sp & 255u) == 0u) { if (xb_ld(&bar[XB_TMO])) break; if (sp > XB_SPIN_CAP) { atomicAdd(&bar[XB_TMO], 1u); break; } }
  }
  nloc = mine > 0u ? mine : 1u; nx = cnt > 0u ? cnt : 1u;
}
__device__ __forceinline__ void xcd_barrier(const XcdBarrier& b) {
  asm volatile("s_waitcnt vmcnt(0)" ::: "memory");
  __syncthreads();
  if (threadIdx.x == 0) {
    unsigned* bar = b.bar;
    __builtin_amdgcn_s_waitcnt(0);
    unsigned nloc = b.st[0], nx = b.st[1];
    if (nloc == 0u) { xcd_barrier_complete(bar, b.x, nloc, nx); b.st[0] = nloc; b.st[1] = nx; }
    const unsigned old = xb_add(&bar[XB_XSUB(b.x)], 1u);
    const unsigned gen = old / nloc;
    if (old + 1u == (gen + 1u) * nloc) {
      __builtin_amdgcn_fence(__ATOMIC_RELEASE, "agent");
      asm volatile("s_waitcnt vmcnt(0)" ::: "memory");
      const unsigned og = xb_add(&bar[XB_TOP], 1u);
      const unsigned tg = og / nx;
      if (og + 1u == (tg + 1u) * nx) xb_add(&bar[XB_TOPGEN], 1u);
      else XB_SPIN(xb_ld(&bar[XB_TOPGEN]) == tg, bar);
      __builtin_amdgcn_fence(__ATOMIC_ACQUIRE, "agent");
      xb_add(&bar[XB_XGEN(b.x)], 1u);
      asm volatile("s_waitcnt vmcnt(0)" ::: "memory");
    } else {
      XB_SPIN(xb_ld(&bar[XB_XGEN(b.x)]) == gen, bar);
      __builtin_amdgcn_fence(__ATOMIC_ACQUIRE, "agent");
      asm volatile("s_waitcnt vmcnt(0)" ::: "memory");
    }
  }
  __syncthreads();
}

constexpr int CV_IN = 42 * 32, CV_OUT = 16 * 32, CV_UP = 88 * 32, CV_DOWN = 16 * 88, CV_TOTAL = CV_IN + CV_OUT + CV_UP + CV_DOWN;
struct CvUnit { const float* src; bf16_t* dst; int K, N, k0, n0, perm; };
__device__ __forceinline__ CvUnit cv_decode(KP p, int l, int u) {
  CvUnit c;
  if (u < CV_IN) { c.src = p->w_in + (size_t)l * DM * NIN; c.dst = p->Wt_in; c.K = DM; c.N = NIN; c.k0 = (u / 42) * 64; c.n0 = (u % 42) * 128; c.perm = 0; }
  else if (u < CV_IN + CV_OUT) { const int v = u - CV_IN; c.src = p->w_out + (size_t)l * DM * DM; c.dst = p->Wt_out; c.K = DM; c.N = DM; c.k0 = (v / 16) * 64; c.n0 = (v % 16) * 128; c.perm = 0; }
  else if (u < CV_IN + CV_OUT + CV_UP) { const int v = u - CV_IN - CV_OUT; c.src = p->w_up + (size_t)l * DM * 2 * DFF; c.dst = p->Wt_up; c.K = DM; c.N = 2 * DFF; c.k0 = (v / 88) * 64; c.n0 = (v % 88) * 128; c.perm = 1; }
  else { const int v = u - CV_IN - CV_OUT - CV_UP; c.src = p->w_down + (size_t)l * DFF * DM; c.dst = p->Wt_down; c.K = DFF; c.N = DM; c.k0 = (v / 16) * 64; c.n0 = (v % 16) * 128; c.perm = 0; }
  return c;
}
__device__ __forceinline__ void conv_phase(KP p, int wv, int l, char* lds, const int u_lo, const int u_hi, const int bstart) {
  p = relaunder(p);
  float* tile = (float*)lds;
  const int tid = otid(wv);
  const int lk = tid >> 5, ln = (tid & 31) * 4;
  const int sn = tid >> 2, sk = (tid & 3) * 16;
  if ((int)blockIdx.x < bstart) return;
  const int ustride = (int)gridDim.x - bstart;
  int u = u_lo + (int)blockIdx.x - bstart;
  if (u >= u_hi) return;
  CvUnit c = cv_decode(p, l, u);
  f32x4 r[4];
#define CVLOAD() do { _Pragma("unroll") for (int i = 0; i < 4; ++i) { r[i] = (f32x4){0.f, 0.f, 0.f, 0.f}; \
    if (c.n0 + ln < c.N) r[i] = __builtin_nontemporal_load((const f32x4*)(c.src + (size_t)(c.k0 + lk + 16 * i) * c.N + c.n0 + ln)); } } while (0)
  CVLOAD();
  for (;;) {
#pragma unroll
    for (int i = 0; i < 4; ++i) {
#pragma unroll
      for (int j = 0; j < 4; ++j) tile[(lk + 16 * i) * 129 + ln + j] = r[i][j];
    }
    const CvUnit cur = c;
    const int un = u + ustride; const bool more = un < u_hi;
    if (more) { c = cv_decode(p, l, un); CVLOAD(); }
    __syncthreads();
    {
      int drow = cur.n0 + sn;
      if (cur.perm) { const bool isv = cur.n0 >= DFF; const int j0 = isv ? cur.n0 - DFF : cur.n0; drow = (j0 >> 7) * 256 + (isv ? 128 : 0) + sn; }
      u32x4 w0, w1;
#pragma unroll
      for (int q = 0; q < 4; ++q) w0[q] = cvtpk(tile[(sk + 2 * q) * 129 + sn], tile[(sk + 2 * q + 1) * 129 + sn]);
#pragma unroll
      for (int q = 0; q < 4; ++q) w1[q] = cvtpk(tile[(sk + 8 + 2 * q) * 129 + sn], tile[(sk + 8 + 2 * q + 1) * 129 + sn]);
      bf16_t* dp = cur.dst + (size_t)drow * cur.K + cur.k0 + sk;
      *(u32x4*)dp = w0; *(u32x4*)(dp + 8) = w1;
    }
    __syncthreads();
    if (!more) break;
    u = un;
  }
#undef CVLOAD
}

template <int MODE>
__device__ __forceinline__ void gemv9_unit(KP p, int wv, int u, int l1, char* lds) {
  p = relaunder(p);
  const int tid = otid(wv);
  const int l = MODE == 0 ? u / 384 : l1, n0 = (MODE == 0 ? (u % 384) : u) * 32;
  const int NW_ = MODE == 0 ? NMOD : MODE == 1 ? 2 * DFF : NIN;
  if (MODE == 2 && n0 >= NIN) { if (tid < 288) p->sWin[(size_t)(tid >> 5) * ZLD + n0 + (tid & 31)] = 0.f; return; }
  float* sc = (float*)lds;
  for (int i = tid; i < 9 * 2048; i += NTHR) { const int r = i >> 11, k = i & 2047;
    if (MODE == 0) { const float v = (r < 8) ? p->c[r * 2048 + k] : p->c_ctx[k]; sc[i] = silu_f(v); }
    else sc[i] = p->mod[(size_t)(l * 9 + r) * NMOD + (MODE == 1 ? 3 : 0) * DM + k]; }
  __syncthreads();
  const int kg = tid >> 3, cq = tid & 7;
  const float* w = (MODE == 0 ? p->ada_w + (size_t)l * DM * NMOD : MODE == 1 ? p->w_up + (size_t)l * DM * 2 * DFF : p->w_in + (size_t)l * DM * NIN) + (size_t)(kg * 32) * NW_ + n0 + cq * 4;
  f32x4 acc[9];
#pragma unroll
  for (int r = 0; r < 9; ++r) acc[r] = (f32x4){0.f, 0.f, 0.f, 0.f};
#pragma unroll
  for (int kb = 0; kb < 32; kb += 16) {
    f32x4 wv4[16];
#pragma unroll
    for (int j = 0; j < 16; ++j) wv4[j] = __builtin_nontemporal_load((const f32x4*)(w + (size_t)(kb + j) * NW_));
#pragma unroll
    for (int r = 0; r < 9; ++r) {
#pragma unroll
      for (int j4 = 0; j4 < 4; ++j4) {
        const f32x4 s = *(const f32x4*)&sc[r * 2048 + kg * 32 + kb + j4 * 4];
        acc[r] += wv4[j4 * 4 + 0] * s[0] + wv4[j4 * 4 + 1] * s[1] + wv4[j4 * 4 + 2] * s[2] + wv4[j4 * 4 + 3] * s[3];
      }
    }
  }
  __syncthreads();
  float* red = sc;
#pragma unroll
  for (int r = 0; r < 9; ++r) *(f32x4*)&red[(kg * 9 + r) * 32 + cq * 4] = acc[r];
  __syncthreads();
  if (tid < 288) {
    const int r = tid >> 5, cc = tid & 31; float s = MODE == 0 ? p->ada_b[l * NMOD + n0 + cc] : 0.f;
#pragma unroll 8
    for (int g = 0; g < 64; ++g) s += red[(g * 9 + r) * 32 + cc];
    if (MODE == 0) p->mod[(size_t)(l * 9 + r) * NMOD + n0 + cc] = s;
    else if (MODE == 2) p->sWin[(size_t)r * ZLD + n0 + cc] = s;
    else { const int n = n0 + cc, j = n < DFF ? n : n - DFF; p->sW[(size_t)(l * 9 + r) * (2 * DFF) + (j >> 7) * 256 + (n < DFF ? 0 : 128) + (j & 127)] = s; }
  }
  __syncthreads();
}

__device__ __forceinline__ void norm_phase(KP p, int wv, int l, int which, bool from_inputs, bool skip_ctx) {
  p = relaunder(p);
  const int tid_ = otid(wv); const int wid = wv, lane = tid_ & 63;
  const float* g = (which ? p->norm2_g : p->norm1_g) + l * DM;
  for (int row0 = (blockIdx.x * 8 + wid) * 2; row0 < NROWS; row0 += gridDim.x * 16) {
    const float* xr[2]; const float* mrow[2];
#pragma unroll
    for (int q = 0; q < 2; ++q) { const int row = row0 + q, b = row / RPB, rb = row % RPB; const bool isctx = rb < CTX;
      xr[q] = from_inputs ? (isctx ? p->ctx + (size_t)(b * CTX + rb) * DM : p->x + (size_t)(b * SEQ + rb - CTX) * DM) : p->X + (size_t)row * DM;
      mrow[q] = p->mod + (size_t)(l * 9 + (isctx ? 8 : b)) * NMOD + (which ? 3 : 0) * DM; }
    f32x4 v[2][8];
#pragma unroll
    for (int q = 0; q < 2; ++q)
#pragma unroll
      for (int i = 0; i < 8; ++i) v[q][i] = *(const f32x4*)(xr[q] + i * 256 + lane * 4);
#pragma unroll
    for (int q = 0; q < 2; ++q) {
      const int row = row0 + q;
      if (skip_ctx && (row % RPB) < CTX) continue;
      float ss = 0.f;
#pragma unroll
      for (int i = 0; i < 8; ++i) ss += v[q][i][0] * v[q][i][0] + v[q][i][1] * v[q][i][1] + v[q][i][2] * v[q][i][2] + v[q][i][3] * v[q][i][3];
      ss = wave_sum(ss);
      const float r = rsqrtf(ss * (1.f / DM) + EPS);
#pragma unroll
      for (int i = 0; i < 8; ++i) {
        const int col = i * 256 + lane * 4;
        const f32x4 gg = *(const f32x4*)(g + col), sh = *(const f32x4*)(mrow[q] + col), sc = *(const f32x4*)(mrow[q] + DM + col);
        const f32x4 o = (v[q][i] * r * gg) * (sc + 1.f) + sh;
        u32x2 w; w[0] = cvtpk(o[0], o[1]); w[1] = cvtpk(o[2], o[3]);
        *(u32x2*)(p->H + (size_t)row * DM + col) = w;
      }
    }
  }
}

namespace g8 {
constexpr int BM = 256, BK = 64, HALF = 128, HT = HALF * BK;
__device__ __forceinline__ int lds_byte(int r, int c) { const int st = (r >> 4) * 2 + (c >> 5), rr = r & 15, cc = c & 31, ob = rr * 64 + cc * 2; return st * 1024 + (ob ^ (((ob >> 9) & 1) << 5)); }
__device__ __forceinline__ void stage_rc(int b, int& R, int& C) { const int st = b / 1024, sb = b % 1024, swz = sb ^ (((sb >> 9) & 1) << 5); R = (st >> 1) * 16 + swz / 64; C = (st & 1) * 32 + (swz % 64) / 2; }
}
typedef __attribute__((address_space(3))) unsigned lds_u32;

template <class Epi>
__device__ __forceinline__ void gemm_tile(const bf16_t* __restrict__ A, const int lda, const bf16_t* __restrict__ Bt, const int ldb, const int K,
                                          const int brow, const int bcol, char* shmc, Epi& epi, const int wv, const bool pre = false, const int nbrow = -1, const int nbcol = -1) {
  using namespace g8;
  typedef __attribute__((address_space(3))) unsigned char lds_u8;
  lds_u8* lds = (lds_u8*)shmc;
  const int tid = otid(wv);
  const int wid = wv, lane = tid & 63, wr = wid >> 2, wc = wid & 3, fr = lane & 15, fq = lane >> 4;
  constexpr int HTB = HT * 2;
  unsigned voffA[2], voffB[2];
#pragma unroll
  for (int i = 0; i < 2; ++i) { int R, C; stage_rc(tid * 16 + i * 8192, R, C); voffA[i] = (unsigned)(R * lda + C) * 2u; voffB[i] = (unsigned)(R * ldb + C) * 2u; }
  const size_t kstep = (size_t)(BK * 2);
  const size_t hstepA = (size_t)HALF * lda * 2, hstepB = (size_t)HALF * ldb * 2;
  const unsigned ldsw = (unsigned)wid * 1024u;
  const int aoff = lds_byte(wr * 64 + fr, fq * 8), boff = lds_byte(wc * 32 + fr, fq * 8);
  const char* cA = (const char*)A + (size_t)brow * lda * 2; const char* cB = (const char*)Bt + (size_t)bcol * ldb * 2;
#define SA(b, h) (((b) * 2 + (h)) * HTB)
#define SB(b, h) ((4 + (b) * 2 + (h)) * HTB)
#define STAGE(bufoff, gbase, voff) do { _Pragma("unroll") for (int _i = 0; _i < 2; ++_i) \
    __builtin_amdgcn_global_load_lds((const unsigned*)((const char*)(gbase) + (voff)[_i]), (lds_u32*)(lds + (bufoff) + ldsw + _i * 8192), 16, 0, 0); } while (0)
#define LDA(dst, b, h) do { _Pragma("unroll") for (int m = 0; m < 4; ++m) _Pragma("unroll") for (int k = 0; k < 2; ++k) dst[m][k] = *(const __attribute__((address_space(3))) bf16x8*)(lds + SA(b, h) + aoff + m * 2048 + k * 1024); } while (0)
#define LDB(dst, b, h) do { _Pragma("unroll") for (int n = 0; n < 2; ++n) _Pragma("unroll") for (int k = 0; k < 2; ++k) dst[n][k] = *(const __attribute__((address_space(3))) bf16x8*)(lds + SB(b, h) + boff + n * 2048 + k * 1024); } while (0)
#define MMA(ai, bj, At_, Bt_) do { __builtin_amdgcn_s_setprio(1); _Pragma("unroll") for (int m = 0; m < 4; ++m) _Pragma("unroll") for (int n = 0; n < 2; ++n) _Pragma("unroll") for (int k = 0; k < 2; ++k) \
      acc[ai][bj][m][n] = __builtin_amdgcn_mfma_f32_16x16x32_bf16(Bt_[n][k], At_[m][k], acc[ai][bj][m][n], 0, 0, 0); __builtin_amdgcn_s_setprio(0); } while (0)
#define WAIT_V(n) asm volatile("s_waitcnt vmcnt(" #n ")" ::: "memory")
#define WAIT_L(n) asm volatile("s_waitcnt lgkmcnt(" #n ")" ::: "memory")
#define BAR __builtin_amdgcn_s_barrier()
#define SCHED __builtin_amdgcn_sched_barrier(0)
  f32x4 acc[2][2][4][2];
#pragma unroll
  for (int a = 0; a < 2; ++a)
#pragma unroll
    for (int b = 0; b < 2; ++b)
#pragma unroll
      for (int m = 0; m < 4; ++m)
#pragma unroll
        for (int n = 0; n < 2; ++n) acc[a][b][m][n] = (f32x4){0.f, 0.f, 0.f, 0.f};
  bf16x8 At[4][2], B0[2][2], B1[2][2];
  const int nt = K / BK;
  if (!pre) { STAGE(SB(0, 0), cB, voffB); STAGE(SA(0, 0), cA, voffA); STAGE(SB(0, 1), cB + hstepB, voffB); STAGE(SA(0, 1), cA + hstepA, voffA); }
  if (wr == 1) BAR;
  WAIT_V(4); BAR;
  STAGE(SB(1, 0), cB + kstep, voffB); STAGE(SA(1, 0), cA + kstep, voffA); STAGE(SB(1, 1), cB + hstepB + kstep, voffB);
  WAIT_V(6); BAR;
  for (int t = 0; t < nt - 2; t += 2) {
    const char* a1 = cA + (size_t)(t + 1) * kstep;
    const char* a2 = cA + (size_t)(t + 2) * kstep; const char* b2 = cB + (size_t)(t + 2) * kstep;
    const char* a3 = a2 + kstep; const char* b3 = b2 + kstep;
    LDB(B0, 0, 0); SCHED; LDA(At, 0, 0); STAGE(SA(1, 1), a1 + hstepA, voffA);
    WAIT_L(8); BAR; WAIT_L(0); MMA(0, 0, At, B0); BAR; SCHED;
    LDB(B1, 0, 1); STAGE(SB(0, 0), b2, voffB);
    BAR; WAIT_L(0); MMA(0, 1, At, B1); BAR;
    LDA(At, 0, 1); STAGE(SA(0, 0), a2, voffA);
    BAR; WAIT_L(0); MMA(1, 0, At, B0); BAR; SCHED;
    STAGE(SB(0, 1), b2 + hstepB, voffB);
    WAIT_V(6); BAR; MMA(1, 1, At, B1); BAR;
    LDB(B0, 1, 0); SCHED; LDA(At, 1, 0); STAGE(SA(0, 1), a2 + hstepA, voffA);
    WAIT_L(8); BAR; WAIT_L(0); MMA(0, 0, At, B0); BAR; SCHED;
    LDB(B1, 1, 1); STAGE(SB(1, 0), b3, voffB);
    BAR; WAIT_L(0); MMA(0, 1, At, B1); BAR;
    LDA(At, 1, 1); STAGE(SA(1, 0), a3, voffA);
    BAR; WAIT_L(0); MMA(1, 0, At, B0); BAR; SCHED;
    STAGE(SB(1, 1), b3 + hstepB, voffB);
    WAIT_V(6); BAR; MMA(1, 1, At, B1); BAR;
  }
  { const char* a1 = cA + (size_t)(nt - 1) * kstep;
    LDB(B0, 0, 0); LDA(At, 0, 0); STAGE(SA(1, 1), a1 + hstepA, voffA);
    BAR; WAIT_L(0); MMA(0, 0, At, B0); BAR;
    LDB(B1, 0, 1); BAR; WAIT_L(0); MMA(0, 1, At, B1); BAR;
    LDA(At, 0, 1); WAIT_V(4); BAR; WAIT_L(0); MMA(1, 0, At, B0); MMA(1, 1, At, B1); BAR; }
  { LDB(B0, 1, 0); LDA(At, 1, 0); WAIT_V(2); BAR; WAIT_L(0); MMA(0, 0, At, B0); BAR;
    LDB(B1, 1, 1); WAIT_V(0); BAR; WAIT_L(0); MMA(0, 1, At, B1); BAR;
    LDA(At, 1, 1); BAR; WAIT_L(0); MMA(1, 0, At, B0); MMA(1, 1, At, B1); BAR; }
  if (wr == 0) BAR;
  __syncthreads();
  __builtin_amdgcn_sched_barrier(0);
  if (nbrow >= 0) { const char* nA = (const char*)A + (size_t)nbrow * lda * 2; const char* nB = (const char*)Bt + (size_t)nbcol * ldb * 2;
    const int t2 = otid(wv); unsigned vA2[2], vB2[2];
#pragma unroll
    for (int i = 0; i < 2; ++i) { int R, C; stage_rc(t2 * 16 + i * 8192, R, C); vA2[i] = (unsigned)(R * lda + C) * 2u; vB2[i] = (unsigned)(R * ldb + C) * 2u; }
    STAGE(SB(0, 0), nB, vB2); STAGE(SA(0, 0), nA, vA2); STAGE(SB(0, 1), nB + hstepB, vB2); STAGE(SA(0, 1), nA + hstepA, vA2); }
  epi(acc, brow, bcol, wr, wc, fr, fq, shmc);
  __syncthreads();
#undef SA
#undef SB
#undef STAGE
#undef LDA
#undef LDB
#undef MMA
}

__device__ __forceinline__ void tile_map(int L, int nM, int nN, int& pm, int& pn, const int WGM = 8) {
  const int nwg = nM * nN; int wgid = L;
  { const int q = nwg / 8, r = nwg % 8, xcd = wgid % 8, off = wgid / 8; wgid = (xcd < r ? xcd * (q + 1) : r * (q + 1) + (xcd - r) * q) + off; }
  const int nig = WGM * nN, gid = wgid / nig, fm = gid * WGM, gsz = (nM - fm) < WGM ? (nM - fm) : WGM;
  pm = fm + ((wgid % nig) % gsz); pn = (wgid % nig) / gsz;
}

template <bool NORM>
struct EpiBf16 {
  bf16_t* O; int ldo; const float* ssq; const float* sWr;
  __device__ __forceinline__ void operator()(f32x4 (&acc)[2][2][4][2], int brow, int bcol, int wr, int wc, int fr, int fq, char*) const {
    if (NORM) {
      float rs[2][4];
#pragma unroll
      for (int ai = 0; ai < 2; ++ai)
#pragma unroll
        for (int m = 0; m < 4; ++m) rs[ai][m] = rsqrtf(ssq[brow + ai * 128 + wr * 64 + m * 16 + fr] * (1.f / DM) + EPS);
#pragma unroll
      for (int bj = 0; bj < 2; ++bj)
#pragma unroll
        for (int n = 0; n < 2; ++n) { const f32x4 sw = *(const f32x4*)(sWr + bcol + bj * 128 + wc * 32 + n * 16 + fq * 4);
#pragma unroll
          for (int ai = 0; ai < 2; ++ai)
#pragma unroll
            for (int m = 0; m < 4; ++m) acc[ai][bj][m][n] = acc[ai][bj][m][n] * rs[ai][m] + sw; }
    }
#pragma unroll
    for (int ai = 0; ai < 2; ++ai)
#pragma unroll
      for (int m = 0; m < 4; ++m) {
        bf16_t* rowp = O + (size_t)(brow + ai * 128 + wr * 64 + m * 16 + fr) * ldo + bcol + wc * 32 + fq * 4;
#pragma unroll
        for (int bj = 0; bj < 2; ++bj)
#pragma unroll
          for (int n = 0; n < 2; ++n) { const f32x4 a = acc[ai][bj][m][n]; u32x2 w; w[0] = cvtpk(a[0], a[1]); w[1] = cvtpk(a[2], a[3]); *(u32x2*)(rowp + bj * 128 + n * 16) = w; }
      }
  }
};
struct EpiRes {
  const float* base; long base_row0; float* X; const float* gate;
  __device__ __forceinline__ void operator()(f32x4 (&acc)[2][2][4][2], int brow, int bcol, int wr, int wc, int fr, int fq, char*) const {
    f32x4 g[2][2];
#pragma unroll
    for (int bj = 0; bj < 2; ++bj)
#pragma unroll
      for (int n = 0; n < 2; ++n) g[bj][n] = *(const f32x4*)(gate + bcol + bj * 128 + wc * 32 + n * 16 + fq * 4);
#pragma unroll
    for (int ai = 0; ai < 2; ++ai)
#pragma unroll
      for (int m = 0; m < 4; ++m) {
        if (m == 0 || m == 2) __builtin_amdgcn_sched_barrier(0);
        const long row = brow + ai * 128 + wr * 64 + m * 16 + fr; const int col0 = bcol + wc * 32 + fq * 4;
        const float* bp = base + (size_t)(row - base_row0) * DM + col0; float* xp = X + (size_t)row * DM + col0;
#pragma unroll
        for (int bj = 0; bj < 2; ++bj)
#pragma unroll
          for (int n = 0; n < 2; ++n) { const f32x4 bv = *(const f32x4*)(bp + bj * 128 + n * 16); *(f32x4*)(xp + bj * 128 + n * 16) = bv + g[bj][n] * acc[ai][bj][m][n]; }
      }
  }
};
struct EpiOut {
  const float* base; long base_row0; float* X; const float* gate; const float* n2g; const float* scl; bf16_t* H2; float* ssq;
  __device__ __forceinline__ void operator()(f32x4 (&acc)[2][2][4][2], int brow, int bcol, int wr, int wc, int fr, int fq, char*) const {
    f32x4 g[2][2], gm[2][2];
#pragma unroll
    for (int bj = 0; bj < 2; ++bj)
#pragma unroll
      for (int n = 0; n < 2; ++n) { const int col = bcol + bj * 128 + wc * 32 + n * 16 + fq * 4; g[bj][n] = *(const f32x4*)(gate + col); gm[bj][n] = *(const f32x4*)(n2g + col) * (*(const f32x4*)(scl + col) + 1.f); }
#pragma unroll
    for (int ai = 0; ai < 2; ++ai)
#pragma unroll
      for (int m = 0; m < 4; ++m) {
        const long row = brow + ai * 128 + wr * 64 + m * 16 + fr; const int col0 = bcol + wc * 32 + fq * 4;
        const float* bp = base + (size_t)(row - base_row0) * DM + col0; float* xp = X + (size_t)row * DM + col0; bf16_t* hp = H2 + (size_t)row * DM + col0;
        float ss = 0.f;
#pragma unroll
        for (int bj = 0; bj < 2; ++bj)
#pragma unroll
          for (int n = 0; n < 2; ++n) {
            const f32x4 xn = *(const f32x4*)(bp + bj * 128 + n * 16) + g[bj][n] * acc[ai][bj][m][n];
            *(f32x4*)(xp + bj * 128 + n * 16) = xn;
            ss += xn[0] * xn[0] + xn[1] * xn[1] + xn[2] * xn[2] + xn[3] * xn[3];
            const f32x4 hv = xn * gm[bj][n];
            u32x2 w; w[0] = cvtpk(hv[0], hv[1]); w[1] = cvtpk(hv[2], hv[3]);
            *(u32x2*)(hp + bj * 128 + n * 16) = w;
          }
        ss += swz_xor<16>(ss);
        { auto rr = __builtin_amdgcn_permlane32_swap(__float_as_uint(ss), __float_as_uint(ss), false, false); ss = __uint_as_float(rr[0]) + __uint_as_float(rr[1]); }
        if (fq == 0) (void)__hip_atomic_fetch_add(ssq + row, ss, __ATOMIC_RELAXED, __HIP_MEMORY_SCOPE_AGENT);
      }
  }
};
struct EpiUp {
  const float* cw; const float* cb; bf16_t* U; float* HA; float* HB; int pm, pn; const float* ssq; const float* sWr;
  __device__ __forceinline__ void operator()(f32x4 (&acc)[2][2][4][2], int brow, int bcol, int wr, int wc, int fr, int fq, char* lds) const {
    constexpr int AST = 272;
    { float rs[2][4];
#pragma unroll
      for (int ai = 0; ai < 2; ++ai)
#pragma unroll
        for (int m = 0; m < 4; ++m) rs[ai][m] = rsqrtf(ssq[brow + ai * 128 + wr * 64 + m * 16 + fr] * (1.f / DM) + EPS);
#pragma unroll
      for (int bj = 0; bj < 2; ++bj)
#pragma unroll
        for (int n = 0; n < 2; ++n) { const f32x4 sw = *(const f32x4*)(sWr + bcol + bj * 128 + wc * 32 + n * 16 + fq * 4);
#pragma unroll
          for (int ai = 0; ai < 2; ++ai)
#pragma unroll
            for (int m = 0; m < 4; ++m) acc[ai][bj][m][n] = acc[ai][bj][m][n] * rs[ai][m] + sw; } }
#pragma unroll
    for (int ai = 0; ai < 2; ++ai)
#pragma unroll
      for (int m = 0; m < 4; ++m)
#pragma unroll
        for (int n = 0; n < 2; ++n) { const f32x4 a = acc[ai][0][m][n]; u32x2 w; w[0] = cvtpk(a[0], a[1]); w[1] = cvtpk(a[2], a[3]);
          *(u32x2*)(lds + (ai * 128 + wr * 64 + m * 16 + fr) * AST + (wc * 32 + n * 16 + fq * 4) * 2) = w; }
    __syncthreads();
    f32x4 w0[2], w1[2], w2[2], bb[2];
#pragma unroll
    for (int n = 0; n < 2; ++n) { const int f = pn * 128 + wc * 32 + n * 16 + fq * 4;
      w0[n] = *(const f32x4*)(cw + f); w1[n] = *(const f32x4*)(cw + DFF + f); w2[n] = *(const f32x4*)(cw + 2 * DFF + f); bb[n] = *(const f32x4*)(cb + f); }
#pragma unroll
    for (int ai = 0; ai < 2; ++ai)
#pragma unroll
      for (int m = 0; m < 4; ++m) {
        const int rl = ai * 128 + wr * 64 + m * 16 + fr;
#pragma unroll
        for (int n = 0; n < 2; ++n) {
          const int c = wc * 32 + n * 16 + fq * 4;
          f32x4 up = {0.f, 0.f, 0.f, 0.f}, dn = {0.f, 0.f, 0.f, 0.f};
          if (rl > 0) { const u32x2 r = *(const u32x2*)(lds + (rl - 1) * AST + c * 2); up[0] = __uint_as_float(r[0] << 16); up[1] = __uint_as_float(r[0] & 0xffff0000u); up[2] = __uint_as_float(r[1] << 16); up[3] = __uint_as_float(r[1] & 0xffff0000u); }
          if (rl < 255) { const u32x2 r = *(const u32x2*)(lds + (rl + 1) * AST + c * 2); dn[0] = __uint_as_float(r[0] << 16); dn[1] = __uint_as_float(r[0] & 0xffff0000u); dn[2] = __uint_as_float(r[1] << 16); dn[3] = __uint_as_float(r[1] & 0xffff0000u); }
          const f32x4 a = acc[ai][0][m][n], v = acc[ai][1][m][n];
          const f32x4 cv = up * w0[n] + a * w1[n] + dn * w2[n] + bb[n];
          float u[4];
#pragma unroll
          for (int j = 0; j < 4; ++j) u[j] = silu_f(cv[j]) * v[j];
          u32x2 w; w[0] = cvtpk(u[0], u[1]); w[1] = cvtpk(u[2], u[3]);
          const int f = pn * 128 + c;
          *(u32x2*)(U + (size_t)(brow + rl) * DFF + f) = w;
          if (rl == 0 || rl == 255) {
            const int e = rl == 0 ? 0 : 1;
            *(f32x4*)(HA + ((size_t)(pm * 2 + e)) * DFF + f) = a;
            float* hb = HB + (((size_t)(pm * 2 + e)) * DFF + f) * 2;
            *(f32x4*)(hb) = (f32x4){cv[0], v[0], cv[1], v[1]};
            *(f32x4*)(hb + 4) = (f32x4){cv[2], v[2], cv[3], v[3]};
          }
        }
      }
  }
};

namespace at {
constexpr int D = 128, NW = 8, QBLK = 32, KVBLK = 64;
constexpr float SCALE = 0.088388347648318440f;
constexpr float THR = 8.f;
constexpr int LDQ = ZLD, LDK = 128, LDO = DM;
constexpr size_t SHM_V = KVBLK * D * 2, SHM_K = KVBLK * D * 2;
#define KSWZ(row, colB) ((row) * 256 + ((colB) ^ (((row) & 7) << 4)))
#define SBAR() __builtin_amdgcn_sched_barrier(0)
__device__ __forceinline__ int crow(int r, int hi) { return (r & 3) + 8 * (r >> 2) + 4 * hi; }
__device__ __forceinline__ void partialSM(f32x16& p0, f32x16& p1, float& m_reg, float& mn, float& alpha) {
  constexpr float C = SCALE * 1.4426950408889634f;
  float pmax = p0[0]; for (int r = 1; r < 16; ++r) pmax = fmaxf(pmax, p0[r]); for (int r = 0; r < 16; ++r) pmax = fmaxf(pmax, p1[r]);
  { auto rr = __builtin_amdgcn_permlane32_swap(__float_as_uint(pmax), __float_as_uint(pmax), false, false);
    pmax = fmaxf(__uint_as_float(rr[0]), __uint_as_float(rr[1])); }
  if (__builtin_expect(__all(pmax - m_reg <= THR / SCALE), 1)) { mn = m_reg; alpha = 1.f; }
  else { mn = fmaxf(m_reg, pmax); alpha = __builtin_amdgcn_exp2f((m_reg - mn) * C); m_reg = mn; }
  float mnC = -mn * C;
  for (int r = 0; r < 16; ++r) p0[r] = fmaf(p0[r], C, mnC); for (int r = 0; r < 16; ++r) p1[r] = fmaf(p1[r], C, mnC);
  for (int r = 0; r < 16; ++r) p0[r] = __builtin_amdgcn_exp2f(p0[r]);
}
__device__ __forceinline__ void finishSM(f32x16& p0, f32x16& p1, float alpha, float& l_reg, bf16x8& pa0, bf16x8& pa1, bf16x8& pa2, bf16x8& pa3) {
  for (int r = 0; r < 16; ++r) p1[r] = __builtin_amdgcn_exp2f(p1[r]);
  float ps = 0; for (int r = 0; r < 16; ++r) ps += p0[r]; for (int r = 0; r < 16; ++r) ps += p1[r];
  { auto rr = __builtin_amdgcn_permlane32_swap(__float_as_uint(ps), __float_as_uint(ps), false, false);
    ps = __uint_as_float(rr[0]) + __uint_as_float(rr[1]); }
  l_reg = l_reg * alpha + ps;
#define PK4(P, BASE, OUT) do { unsigned a0 = cvtpk_asm(P[BASE + 0], P[BASE + 1]), a1 = cvtpk_asm(P[BASE + 2], P[BASE + 3]);   \
    unsigned b0 = cvtpk_asm(P[BASE + 4], P[BASE + 5]), b1 = cvtpk_asm(P[BASE + 6], P[BASE + 7]);                              \
    auto r0 = __builtin_amdgcn_permlane32_swap(a0, b0, false, false); auto r1 = __builtin_amdgcn_permlane32_swap(a1, b1, false, false); \
    u32x4 w = {r0[0], r1[0], r0[1], r1[1]}; OUT = *reinterpret_cast<bf16x8*>(&w); } while (0)
  PK4(p0, 0, pa0); PK4(p0, 8, pa1); PK4(p1, 0, pa2); PK4(p1, 8, pa3);
#undef PK4
}
__device__ __forceinline__ void qkt(f32x16& p0, f32x16& p1, const bf16_t* Ks, const bf16x8* qr, int r32, int hi) {
  p0 = f32x16{}; p1 = f32x16{};
  for (int d0 = 0; d0 < 8; ++d0) { int cb = (d0 * 16 + hi * 8) * 2;
    bf16x8 b0 = *reinterpret_cast<const bf16x8*>((const char*)Ks + KSWZ(r32, cb));
    bf16x8 b1 = *reinterpret_cast<const bf16x8*>((const char*)Ks + KSWZ(32 + r32, cb));
    p0 = __builtin_amdgcn_mfma_f32_32x32x16_bf16(b0, qr[d0], p0, 0, 0, 0);
    p1 = __builtin_amdgcn_mfma_f32_32x32x16_bf16(b1, qr[d0], p1, 0, 0, 0); }
}
__device__ __forceinline__ int v_st(int k, int c) { const int kk = (k & ~0xC) | ((k & 4) << 1) | ((k & 8) >> 1); return ((kk >> 3) * 4 + (c >> 5)) * 512 + ((kk & 7) * 32 + (c & 31)) * 2; }
__device__ __forceinline__ int v_rd_base(int lane) { return ((lane & 3) << 3) | (((lane >> 2) & 3) << 6) | (((lane >> 4) & 1) << 5) | (((lane >> 5) & 1) << 8); }
constexpr int v_rd_off(int d0, int ks, int half) { return d0 * 512 + ks * 4096 + half * 2048; }
template <int OFF> __device__ __forceinline__ s16x4 tr_read(int vb) {
  s16x4 r; asm volatile("ds_read_b64_tr_b16 %0, %1 offset:%2" : "=&v"(r) : "v"(vb), "i"(OFF) : "memory"); return r;
}
template <int D0> __device__ __forceinline__ void pv_one(f32x16& od, int vb, bf16x8 pa0, bf16x8 pa1, bf16x8 pa2, bf16x8 pa3) {
  const s16x4 l0 = tr_read<v_rd_off(D0, 0, 0)>(vb), h0 = tr_read<v_rd_off(D0, 0, 1)>(vb), l1 = tr_read<v_rd_off(D0, 1, 0)>(vb), h1 = tr_read<v_rd_off(D0, 1, 1)>(vb);
  const s16x4 l2 = tr_read<v_rd_off(D0, 2, 0)>(vb), h2 = tr_read<v_rd_off(D0, 2, 1)>(vb), l3 = tr_read<v_rd_off(D0, 3, 0)>(vb), h3 = tr_read<v_rd_off(D0, 3, 1)>(vb);
  asm volatile("s_waitcnt lgkmcnt(0)" ::: "memory"); SBAR();
#define PK(L, H) (bf16x8){L[0], L[1], L[2], L[3], H[0], H[1], H[2], H[3]}
  od = __builtin_amdgcn_mfma_f32_32x32x16_bf16(pa0, PK(l0, h0), od, 0, 0, 0);
  od = __builtin_amdgcn_mfma_f32_32x32x16_bf16(pa1, PK(l1, h1), od, 0, 0, 0);
  od = __builtin_amdgcn_mfma_f32_32x32x16_bf16(pa2, PK(l2, h2), od, 0, 0, 0);
  od = __builtin_amdgcn_mfma_f32_32x32x16_bf16(pa3, PK(l3, h3), od, 0, 0, 0);
#undef PK
}
__device__ __forceinline__ void pv_d0(f32x16* o, int vb, bf16x8 pa0, bf16x8 pa1, bf16x8 pa2, bf16x8 pa3) {
  pv_one<0>(o[0], vb, pa0, pa1, pa2, pa3); pv_one<1>(o[1], vb, pa0, pa1, pa2, pa3); pv_one<2>(o[2], vb, pa0, pa1, pa2, pa3); pv_one<3>(o[3], vb, pa0, pa1, pa2, pa3);
}
__device__ __forceinline__ void attn_dense_body(const bf16_t* __restrict__ Qb, const bf16_t* __restrict__ Kh, const bf16_t* __restrict__ Vh,
                                                bf16_t* __restrict__ Ob, int seq, char* lds, int wv) {
  const int tid = otid(wv), wid = wv, lane = tid & 63, r32 = lane & 31, hi = lane >> 5;
  bf16_t* V_lds = (bf16_t*)lds; bf16_t* K_lds = (bf16_t*)(lds + 2 * SHM_V);
  float* ws = (float*)(lds + 2 * SHM_V + 2 * SHM_K) + wid * 64; float* li_l = ws; float* al_l = ws + 32;
  float m_reg = -1e30f, l_reg = 0; f32x16 o[4] = {}; bf16x8 qr[8];
  const bf16_t* Qw = Qb + (long)(wid * QBLK + r32) * LDQ + hi * 8;
#pragma unroll
  for (int d0 = 0; d0 < 8; ++d0) qr[d0] = *reinterpret_cast<const bf16x8*>(Qw + d0 * 16);
  const int sr = tid >> 4, sc = (tid & 15) * 8, vst0 = v_st(sr, sc), vst1 = v_st(32 + sr, sc);
  const int vb0 = (int)(uintptr_t)V_lds + v_rd_base(lane);
  struct { bf16x8 vs0, vs1, ks0, ks1; } sr_[2];
#define SLOAD(i, k0) do { sr_[i].vs0 = *reinterpret_cast<const bf16x8*>(&Vh[(long)((k0) + sr) * LDK + sc]); sr_[i].vs1 = *reinterpret_cast<const bf16x8*>(&Vh[(long)((k0) + 32 + sr) * LDK + sc]); \
    sr_[i].ks0 = *reinterpret_cast<const bf16x8*>(&Kh[(long)((k0) + sr) * LDK + sc]); sr_[i].ks1 = *reinterpret_cast<const bf16x8*>(&Kh[(long)((k0) + 32 + sr) * LDK + sc]); } while (0)
#define SWRITE(b, i) do { *(bf16x8*)((char*)V_lds + (b) * SHM_V + vst0) = sr_[i].vs0;          \
    *(bf16x8*)((char*)V_lds + (b) * SHM_V + vst1) = sr_[i].vs1; int kc = sc * 2;               \
    *(bf16x8*)((char*)K_lds + (b) * SHM_K + KSWZ(sr, kc)) = sr_[i].ks0;                       \
    *(bf16x8*)((char*)K_lds + (b) * SHM_K + KSWZ(32 + sr, kc)) = sr_[i].ks1; } while (0)
#define SWAIT() asm volatile("s_waitcnt vmcnt(4)" ::: "memory")
#define RESC(a) do { if (__any((a) < 1.f)) { if (hi == 0) al_l[r32] = (a); asm volatile("s_waitcnt lgkmcnt(0)" ::: "memory"); \
    for (int d = 0; d < 4; ++d) for (int r = 0; r < 16; ++r) o[d][r] *= al_l[crow(r, hi)]; } } while (0)
  f32x16 pA0, pA1, pB0, pB1; float mnA, mnB, alA, alB; bf16x8 pa0, pa1, pa2, pa3; const int NT = seq / KVBLK;
  constexpr int SE = 0, SO = 1;
  SLOAD(SE, 0); asm volatile("s_waitcnt vmcnt(0)" ::: "memory"); SWRITE(0, SE); __syncthreads();
  qkt(pA0, pA1, K_lds, qr, r32, hi); partialSM(pA0, pA1, m_reg, mnA, alA);
  SLOAD(SO, KVBLK); if (2 < NT) SLOAD(SE, 2 * KVBLK);
  SWAIT(); SWRITE(1, SO); __syncthreads();
  for (int j = 1; j + 1 < NT; j += 2) {
    SBAR(); qkt(pB0, pB1, (bf16_t*)((char*)K_lds + SHM_K), qr, r32, hi);
    finishSM(pA0, pA1, alA, l_reg, pa0, pa1, pa2, pa3); SBAR();
    SLOAD(SO, (j + 2) * KVBLK); SBAR();
    pv_d0(o, vb0, pa0, pa1, pa2, pa3); partialSM(pB0, pB1, m_reg, mnB, alB);
    __syncthreads(); SWAIT(); SWRITE(0, SE);
    RESC(alB); __syncthreads();
    SBAR(); qkt(pA0, pA1, K_lds, qr, r32, hi);
    finishSM(pB0, pB1, alB, l_reg, pa0, pa1, pa2, pa3); SBAR();
    if (j + 3 < NT) SLOAD(SE, (j + 3) * KVBLK); SBAR();
    pv_d0(o, vb0 + (int)SHM_V, pa0, pa1, pa2, pa3); partialSM(pA0, pA1, m_reg, mnA, alA);
    __syncthreads(); SWAIT(); SWRITE(1, SO);
    RESC(alA); __syncthreads();
  }
  SBAR(); qkt(pB0, pB1, (bf16_t*)((char*)K_lds + SHM_K), qr, r32, hi);
  finishSM(pA0, pA1, alA, l_reg, pa0, pa1, pa2, pa3); SBAR();
  pv_d0(o, vb0, pa0, pa1, pa2, pa3); partialSM(pB0, pB1, m_reg, mnB, alB);
  __syncthreads(); RESC(alB);
  finishSM(pB0, pB1, alB, l_reg, pa0, pa1, pa2, pa3); SBAR();
  pv_d0(o, vb0 + (int)SHM_V, pa0, pa1, pa2, pa3);
  if (hi == 0) li_l[r32] = l_reg; asm volatile("s_waitcnt lgkmcnt(0)" ::: "memory");
  float rli[16];
#pragma unroll
  for (int r = 0; r < 16; ++r) rli[r] = __builtin_amdgcn_rcpf(li_l[crow(r, hi)]);
  bf16_t* Ow = Ob + (long)(wid * QBLK) * LDO;
#pragma unroll
  for (int r = 0; r < 16; ++r) { int orow = crow(r, hi);
#pragma unroll
    for (int d0 = 0; d0 < 4; ++d0) Ow[(long)orow * LDO + d0 * 32 + r32] = f2bf(o[d0][r] * rli[r]); }
#undef SLOAD
#undef SWRITE
#undef SWAIT
#undef RESC
}
}

__device__ __forceinline__ void prep_phase(KP p, int wv, int l, char* lds) {
  p = relaunder(p);
  const int tid = otid(wv), wid = tid >> 6, lane = tid & 63;
  const float qg1 = p->q_norm_g[l * 128 + lane], qg2 = p->q_norm_g[l * 128 + 64 + lane];
  const float kg1 = p->k_norm_g[l * 128 + lane], kg2 = p->k_norm_g[l * 128 + 64 + lane];
  const float invf = powf(10000.f, -(float)(lane & 31) / 32.f);
  for (int row = blockIdx.x * 8 + wid; row < NROWS; row += gridDim.x * 8) {
    const int rb = row % RPB; const bool lat = rb >= CTX; const int t = rb - CTX;
    float cs = 1.f, sn = 0.f;
    if (lat) { const float pos = (lane < 32) ? (float)(t >> 6) : (float)(t & 63); const float ang = pos * invf; sincosf(ang, &sn, &cs); }
    bf16_t* zr = p->Z + (size_t)row * ZLD;
    bf16_t r1[18], r2[18];
#pragma unroll
    for (int hs = 0; hs < 18; ++hs) {
      const int col0 = hs < 8 ? C_AQ + hs * 128 : hs < 10 ? C_AK + (hs - 8) * 128 : hs < 14 ? C_RQ + (hs - 10) * 128 : C_RK + (hs - 14) * 128;
      r1[hs] = zr[col0 + lane]; r2[hs] = zr[col0 + 64 + lane];
    }
    const u32x2 vcopy = *(const u32x2*)(zr + C_AV + (lane >> 5) * 128 + (lane & 31) * 4);
#pragma unroll
    for (int hs = 0; hs < 18; ++hs) {
      const int col0 = hs < 8 ? C_AQ + hs * 128 : hs < 10 ? C_AK + (hs - 8) * 128 : hs < 14 ? C_RQ + (hs - 10) * 128 : C_RK + (hs - 14) * 128;
      float x1 = bf2f(r1[hs]), x2 = bf2f(r2[hs]);
      if (hs < 10) {
        const float ss = wave_sum(x1 * x1 + x2 * x2);
        const float r = rsqrtf(ss * (1.f / 128.f) + EPS);
        x1 = x1 * r * (hs < 8 ? qg1 : kg1); x2 = x2 * r * (hs < 8 ? qg2 : kg2);
      }
      if (hs >= 14) { x1 *= 0.088388347648318440f; x2 *= 0.088388347648318440f; }
      const float o1 = x1 * cs - x2 * sn, o2 = x1 * sn + x2 * cs;
      if (hs == 8 || hs == 9) { bf16_t* kc = p->Kc + ((size_t)((row / RPB) * 2 + (hs - 8)) * RPB + rb) * 128; kc[lane] = f2bf(o1); kc[64 + lane] = f2bf(o2); }
      else { zr[col0 + lane] = f2bf(o1); zr[col0 + 64 + lane] = f2bf(o2); }
    }
    { const int kvh = lane >> 5, d4 = (lane & 31) * 4;
      *(u32x2*)(p->Vc + ((size_t)((row / RPB) * 2 + kvh) * RPB + rb) * 128 + d4) = vcopy; }
  }
  {
    const int dir = tid >> 8, col = tid & 255;
    float up[16];
#pragma unroll
    for (int r = 0; r < 16; ++r) up[r] = p->gla_gate_up[((size_t)(l * 2 + dir) * 16 + r) * 256 + col];
    const float bias = p->gla_gate_b[(l * 2 + dir) * 256 + col];
    for (int ch = (int)gridDim.x - 1 - (int)blockIdx.x; ch < NROWS / 64; ch += gridDim.x) {
      float bacc = 0.f;
#pragma unroll 1
      for (int s0 = 0; s0 < 64; s0 += 8) {
        bf16x8 g0[8], g1[8]; bf16_t qv[8], kv[8];
#pragma unroll
        for (int j = 0; j < 8; ++j) {
          const int row = ch * 64 + (dir ? 63 - (s0 + j) : (s0 + j));
          const bf16_t* zr = p->Z + (size_t)row * ZLD;
          g0[j] = *(const bf16x8*)(zr + C_GA + dir * 16); g1[j] = *(const bf16x8*)(zr + C_GA + dir * 16 + 8);
          qv[j] = zr[C_GQ + col]; kv[j] = zr[C_GK + col];
        }
#pragma unroll
        for (int j = 0; j < 8; ++j) {
          const int row = ch * 64 + (dir ? 63 - (s0 + j) : (s0 + j));
          float logit = bias;
#pragma unroll
          for (int r = 0; r < 8; ++r) logit += bf2f((bf16_t)g0[j][r]) * up[r] + bf2f((bf16_t)g1[j][r]) * up[8 + r];
          const float ls = fminf(logit, 0.f) - 0.6931471805599453f * __builtin_amdgcn_logf(1.f + fexp(-fabsf(logit)));
          bacc += ls * (1.f / 16.f);
          const size_t o = ((size_t)dir * NROWS + row) * 256 + col;
          p->GQt[o] = f2bf(bf2f(qv[j]) * 0.125f * fexp(bacc));
          p->GKt[o] = f2bf(bf2f(kv[j]) * fexp(-bacc));
        }
      }
      p->Eend[((size_t)dir * (NROWS / 64) + ch) * 256 + col] = fexp(bacc);
    }
  }
  for (int u = blockIdx.x; u < 2 * DFF / 32; u += gridDim.x) gemv9_unit<1>(p, wv, u, l, lds);
  if (l == 0) for (int u = (int)gridDim.x - 1 - (int)blockIdx.x; u < ZLD / 32; u += gridDim.x) gemv9_unit<2>(p, wv, u, 1, lds);
}

__device__ __forceinline__ int scan_row(int b, int s, int dir) { return b * RPB + (dir == 0 ? s : (s < CTX ? CTX - 1 - s : RPB + CTX - 1 - s)); }

#define MFMA16(a, b, c) __builtin_amdgcn_mfma_f32_16x16x32_bf16(a, b, c, 0, 0, 0)
__device__ __forceinline__ bf16x8 pack8(u32x2 lo, u32x2 hi) { u32x4 w = {lo[0], lo[1], hi[0], hi[1]}; return *reinterpret_cast<bf16x8*>(&w); }

__device__ __forceinline__ void ret_scan_unit(KP p, int wv, int l, int u, bool last, char* lds) {
  p = relaunder(p);
  constexpr int ST = 272, IMG = 128 * ST;
  char* Qs = lds; char* Ks = lds + IMG; char* KTs = lds + 2 * IMG; char* VTs = lds + 3 * IMG;
  const int tid = otid(wv), wid = wv, lane = tid & 63, fr = lane & 15, fq = lane >> 4;
  const int b = u >> 3, h = (u >> 1) & 3, dir = u & 1;
  const float lg2 = p->ret_log_decay[l * 8 + dir * 4 + h] * 1.4426950408889634f;
  const float cdec = __builtin_amdgcn_exp2f(lg2 * 128.f);
  const int sr = tid >> 2, sc = (tid & 3) * 32;
  const float vsc = __builtin_amdgcn_exp2f(lg2 * (float)(127 - sr));
  bf16x8 rq[4], rk[4], rv[4];
#define RLOAD(c) do { const bf16_t* base_ = p->Z + (size_t)scan_row(b, (c) * 128 + sr, dir) * ZLD + h * 128 + sc; \
    _Pragma("unroll") for (int k = 0; k < 4; ++k) { rq[k] = *(const bf16x8*)(base_ + C_RQ + k * 8); rk[k] = *(const bf16x8*)(base_ + C_RK + k * 8); rv[k] = *(const bf16x8*)(base_ + C_RV + k * 8); } } while (0)
  f32x4 S[8];
#pragma unroll
  for (int i = 0; i < 8; ++i) S[i] = (f32x4){0.f, 0.f, 0.f, 0.f};
  RLOAD(0);
#pragma unroll 1
  for (int c = 0; c < 18; ++c) {
#pragma unroll
    for (int k = 0; k < 4; ++k) {
      *(bf16x8*)(Qs + sr * ST + (sc + k * 8) * 2) = rq[k];
      *(bf16x8*)(Ks + sr * ST + (sc + k * 8) * 2) = rk[k];
#pragma unroll
      for (int e = 0; e < 8; ++e) {
        const int d = sc + k * 8 + e;
        *(bf16_t*)(KTs + d * ST + sr * 2) = (bf16_t)rk[k][e];
        *(bf16_t*)(VTs + d * ST + sr * 2) = f2bf(bf2f((bf16_t)rv[k][e]) * vsc);
      }
    }
    if (c + 1 < 18) RLOAD(c + 1);
    __syncthreads();
    bf16x8 vf[4];
#pragma unroll
    for (int ks = 0; ks < 4; ++ks) vf[ks] = *(const bf16x8*)(VTs + (16 * wid + fr) * ST + (ks * 32 + fq * 8) * 2);
    const bool need_out = !(last && c < 2);
    if (need_out) {
      bf16x8 qf[4];
#pragma unroll
      for (int ks = 0; ks < 4; ++ks) qf[ks] = *(const bf16x8*)(Qs + (16 * wid + fr) * ST + (ks * 32 + fq * 8) * 2);
      u32x2 pt[8];
#pragma unroll
      for (int jt = 0; jt < 8; ++jt) {
        pt[jt] = (u32x2){0u, 0u};
        if (jt <= wid) {
          f32x4 a = {0.f, 0.f, 0.f, 0.f};
#pragma unroll
          for (int ks = 0; ks < 4; ++ks) { const bf16x8 kf = *(const bf16x8*)(Ks + (16 * jt + fr) * ST + (ks * 32 + fq * 8) * 2); a = MFMA16(kf, qf[ks], a); }
          if (jt == wid) {
#pragma unroll
            for (int jj = 0; jj < 4; ++jj) if (4 * fq + jj > fr) a[jj] = 0.f;
          }
          pt[jt][0] = cvtpk(a[0], a[1]); pt[jt][1] = cvtpk(a[2], a[3]);
        }
      }
      __syncthreads();
#pragma unroll
      for (int jt = 0; jt < 8; ++jt)
        if (jt <= wid || (jt == wid + 1 && !(wid & 1))) *(u32x2*)(Ks + (16 * wid + fr) * ST + (16 * jt + 4 * fq) * 2) = pt[jt];
      __syncthreads();
      bf16x8 sop[4];
#pragma unroll
      for (int s = 0; s < 4; ++s) { u32x4 w = {cvtpk(S[2 * s][0], S[2 * s][1]), cvtpk(S[2 * s][2], S[2 * s][3]), cvtpk(S[2 * s + 1][0], S[2 * s + 1][1]), cvtpk(S[2 * s + 1][2], S[2 * s + 1][3])}; sop[s] = *reinterpret_cast<bf16x8*>(&w); }
#pragma unroll
      for (int it = 0; it < 8; ++it) {
        f32x4 aO = {0.f, 0.f, 0.f, 0.f}, aT = {0.f, 0.f, 0.f, 0.f};
#pragma unroll
        for (int ks = 0; ks < 4; ++ks) if (ks <= (it >> 1)) { const bf16x8 pf = *(const bf16x8*)(Ks + (16 * it + fr) * ST + (ks * 32 + fq * 8) * 2); aO = MFMA16(vf[ks], pf, aO); }
#pragma unroll
        for (int s = 0; s < 4; ++s) {
          const u32x2 lo = *(const u32x2*)(Qs + (16 * it + fr) * ST + (32 * s + 4 * fq) * 2), hi = *(const u32x2*)(Qs + (16 * it + fr) * ST + (32 * s + 16 + 4 * fq) * 2);
          aT = MFMA16(sop[s], pack8(lo, hi), aT);
        }
        const int i = 16 * it + fr;
        const float sP = __builtin_amdgcn_exp2f(lg2 * (float)(i - 127)), sS = __builtin_amdgcn_exp2f(lg2 * (float)(i + 1));
        { const f32x4 o = aO * sP + aT * sS; u32x2 w; w[0] = cvtpk(o[0], o[1]); w[1] = cvtpk(o[2], o[3]);
          *(u32x2*)(p->RO + ((size_t)dir * NROWS + scan_row(b, c * 128 + i, dir)) * 512 + h * 128 + 16 * wid + 4 * fq) = w; }
      }
    }
#pragma unroll
    for (int td = 0; td < 8; ++td) {
      f32x4 a = S[td] * cdec;
#pragma unroll
      for (int ks = 0; ks < 4; ++ks) { const bf16x8 ktf = *(const bf16x8*)(KTs + (16 * td + fr) * ST + (ks * 32 + fq * 8) * 2); a = MFMA16(ktf, vf[ks], a); }
      S[td] = a;
    }
    __syncthreads();
  }
#undef RLOAD
}

__device__ __forceinline__ void gla_scan_unit(KP p, int wv, int l, int u, bool last, char* lds) {
  p = relaunder(p);
  constexpr int ST = 144;
  char* Qs = lds; char* Ks = lds + 64 * ST; char* KTs = lds + 128 * ST; char* VTs = lds + 192 * ST;
  const int tid = otid(wv), wid = wv, lane = tid & 63, fr = lane & 15, fq = lane >> 4;
  const int b = u >> 3, h = (u >> 1) & 3, dir = u & 1;
  const int sr = tid >> 3, sc8 = (tid & 7) * 8, sc16 = (tid & 7) * 16;
  bf16x8 rq, rk, rv[2];
#define GLOAD(c) do { const int row_ = scan_row(b, (c) * 64 + sr, dir); const size_t o_ = ((size_t)dir * NROWS + row_) * 256 + h * 64 + sc8; \
    rq = *(const bf16x8*)(p->GQt + o_); rk = *(const bf16x8*)(p->GKt + o_); const bf16_t* vb_ = p->Z + (size_t)row_ * ZLD + C_GV + h * 128 + sc16; \
    rv[0] = *(const bf16x8*)(vb_); rv[1] = *(const bf16x8*)(vb_ + 8); } while (0)
  f32x4 S[4];
#pragma unroll
  for (int i = 0; i < 4; ++i) S[i] = (f32x4){0.f, 0.f, 0.f, 0.f};
  GLOAD(0);
#pragma unroll 1
  for (int c = 0; c < 36; ++c) {
    *(bf16x8*)(Qs + sr * ST + sc8 * 2) = rq;
    *(bf16x8*)(Ks + sr * ST + sc8 * 2) = rk;
#pragma unroll
    for (int e = 0; e < 8; ++e) *(bf16_t*)(KTs + (sc8 + e) * ST + sr * 2) = (bf16_t)rk[e];
#pragma unroll
    for (int k = 0; k < 2; ++k)
#pragma unroll
      for (int e = 0; e < 8; ++e) *(bf16_t*)(VTs + (sc16 + k * 8 + e) * ST + sr * 2) = (bf16_t)rv[k][e];
    const int chid = scan_row(b, c * 64 + (dir ? 63 : 0), dir) >> 6;
    f32x4 ee[4];
#pragma unroll
    for (int td = 0; td < 4; ++td) ee[td] = *(const f32x4*)(p->Eend + ((size_t)dir * (NROWS / 64) + chid) * 256 + h * 64 + 16 * td + 4 * fq);
    if (c + 1 < 36) GLOAD(c + 1);
    __syncthreads();
    bf16x8 vf[2];
#pragma unroll
    for (int ks = 0; ks < 2; ++ks) vf[ks] = *(const bf16x8*)(VTs + (16 * wid + fr) * ST + (ks * 32 + fq * 8) * 2);
    const bool need_out = !(last && c < 4);
    if (need_out) {
      const int it = wid >> 1, jt0 = (wid & 1) * 2;
      bf16x8 qf[2];
#pragma unroll
      for (int ks = 0; ks < 2; ++ks) qf[ks] = *(const bf16x8*)(Qs + (16 * it + fr) * ST + (ks * 32 + fq * 8) * 2);
      u32x2 pt[2];
#pragma unroll
      for (int t = 0; t < 2; ++t) {
        const int jt = jt0 + t;
        pt[t] = (u32x2){0u, 0u};
        if (jt <= it) {
          f32x4 a = {0.f, 0.f, 0.f, 0.f};
#pragma unroll
          for (int ks = 0; ks < 2; ++ks) { const bf16x8 kf = *(const bf16x8*)(Ks + (16 * jt + fr) * ST + (ks * 32 + fq * 8) * 2); a = MFMA16(kf, qf[ks], a); }
          if (jt == it) {
#pragma unroll
            for (int jj = 0; jj < 4; ++jj) if (4 * fq + jj > fr) a[jj] = 0.f;
          }
          pt[t][0] = cvtpk(a[0], a[1]); pt[t][1] = cvtpk(a[2], a[3]);
        }
      }
      __syncthreads();
#pragma unroll
      for (int t = 0; t < 2; ++t) *(u32x2*)(Ks + (16 * it + fr) * ST + (16 * (jt0 + t) + 4 * fq) * 2) = pt[t];
      __syncthreads();
      bf16x8 sop[2];
#pragma unroll
      for (int s = 0; s < 2; ++s) { u32x4 w = {cvtpk(S[2 * s][0], S[2 * s][1]), cvtpk(S[2 * s][2], S[2 * s][3]), cvtpk(S[2 * s + 1][0], S[2 * s + 1][1]), cvtpk(S[2 * s + 1][2], S[2 * s + 1][3])}; sop[s] = *reinterpret_cast<bf16x8*>(&w); }
#pragma unroll
      for (int i2 = 0; i2 < 4; ++i2) {
        f32x4 a = {0.f, 0.f, 0.f, 0.f};
#pragma unroll
        for (int ks = 0; ks < 2; ++ks) if (ks <= (i2 >> 1)) { const bf16x8 pf = *(const bf16x8*)(Ks + (16 * i2 + fr) * ST + (ks * 32 + fq * 8) * 2); a = MFMA16(vf[ks], pf, a); }
#pragma unroll
        for (int s = 0; s < 2; ++s) {
          const u32x2 lo = *(const u32x2*)(Qs + (16 * i2 + fr) * ST + (32 * s + 4 * fq) * 2), hi = *(const u32x2*)(Qs + (16 * i2 + fr) * ST + (32 * s + 16 + 4 * fq) * 2);
          a = MFMA16(sop[s], pack8(lo, hi), a);
        }
        { u32x2 w; w[0] = cvtpk(a[0], a[1]); w[1] = cvtpk(a[2], a[3]);
          *(u32x2*)(p->GO + ((size_t)dir * NROWS + scan_row(b, c * 64 + 16 * i2 + fr, dir)) * 512 + h * 128 + 16 * wid + 4 * fq) = w; }
      }
    }
#pragma unroll
    for (int td = 0; td < 4; ++td) {
      f32x4 a = S[td];
#pragma unroll
      for (int ks = 0; ks < 2; ++ks) { const bf16x8 ktf = *(const bf16x8*)(KTs + (16 * td + fr) * ST + (ks * 32 + fq * 8) * 2); a = MFMA16(ktf, vf[ks], a); }
      S[td] = a * ee[td];
    }
    __syncthreads();
  }
#undef GLOAD
}

__device__ __forceinline__ void attn_unit(KP p, int wv, int a, char* lds) {
  p = relaunder(p);
  int b, h, kvh, qrow0, seq;
  if (a < 512) { const int x = a & 7, j = (a >> 3) & 31, rnd = a >> 8; b = rnd * 4 + (x >> 1); kvh = x & 1; h = kvh * 4 + (j >> 3); qrow0 = b * RPB + CTX + (j & 7) * 256; seq = RPB; }
  else { const int c = a - 512; b = c >> 3; h = c & 7; kvh = h >> 2; qrow0 = b * RPB; seq = CTX; }
  const bf16_t* Q = p->Z + (size_t)qrow0 * ZLD + C_AQ + h * 128;
  const bf16_t* Kp = p->Kc + (size_t)(b * 2 + kvh) * RPB * 128;
  const bf16_t* Vp = p->Vc + (size_t)(b * 2 + kvh) * RPB * 128;
  at::attn_dense_body(Q, Kp, Vp, p->H + (size_t)qrow0 * DM + h * 128, seq, lds, wv);
  __syncthreads();
}
__device__ __forceinline__ void mix1_phase(KP p, int wv, int l, bool last, char* lds, volatile LAS unsigned* bc) {
  p = relaunder(p);
  const int i = blockIdx.x;
  {
  if (i < 64) ret_scan_unit(p, wv, l, i, last, lds); else if (i < 128) gla_scan_unit(p, wv, l, i - 64, last, lds);
  }
  for (int u = i + 128; u < 128; u += gridDim.x) { if (u < 64) ret_scan_unit(p, wv, l, u, last, lds); else gla_scan_unit(p, wv, l, u - 64, last, lds); }
  const int q = i & 7, nq = last ? 64 : 72;
  for (;;) {
    unsigned* head = p->ctl + WQ_WORD(l, q); asm volatile("" : "+s"(head));
    volatile LAS unsigned* bcl = bc; asm volatile("" : "+s"(bcl));
    __syncthreads();
    if (otid(wv) == 0) bcl[2] = xb_add(head, 1u);
    __syncthreads();
    const int k = __builtin_amdgcn_readfirstlane((int)bcl[2]);
    if (k >= nq) break;
    attn_unit(p, wv, q + 8 * k, lds);
  }
}

__device__ __forceinline__ void mix2_phase(KP p, int wv, int l, bool last) {
  p = relaunder(p);
  const int tid_ = otid(wv); const int wid = wv, lane = tid_ & 63;
  const float rg1 = p->ret_norm_g[l * 128 + lane], rg2 = p->ret_norm_g[l * 128 + 64 + lane];
  const float gg1 = p->gla_norm_g[l * 128 + lane], gg2 = p->gla_norm_g[l * 128 + 64 + lane];
  for (int row = blockIdx.x * 8 + wid; row < NROWS; row += gridDim.x * 8) {
    if (last && (row % RPB) < CTX) continue;
    float x1[8], x2[8], g1[8], g2[8];
#pragma unroll
    for (int slot = 0; slot < 8; ++slot) {
      const bool isg = slot >= 4; const int h = slot & 3;
      const bf16_t* O = isg ? p->GO : p->RO;
      const size_t o0 = (size_t)row * 512 + h * 128, o1 = ((size_t)NROWS + row) * 512 + h * 128;
      x1[slot] = bf2f(__builtin_nontemporal_load(O + o0 + lane)) + bf2f(__builtin_nontemporal_load(O + o1 + lane)); x2[slot] = bf2f(__builtin_nontemporal_load(O + o0 + 64 + lane)) + bf2f(__builtin_nontemporal_load(O + o1 + 64 + lane));
      const bf16_t* zg = p->Z + (size_t)row * ZLD + (isg ? C_GR : C_RG) + h * 128;
      g1[slot] = bf2f(zg[lane]); g2[slot] = bf2f(zg[64 + lane]);
    }
#pragma unroll
    for (int slot = 0; slot < 8; ++slot) {
      const bool isg = slot >= 4;
      const float ss = wave_sum(x1[slot] * x1[slot] + x2[slot] * x2[slot]);
      const float r = rsqrtf(ss * (1.f / 128.f) + EPS);
      bf16_t* hp = p->H + (size_t)row * DM + 1024 + slot * 128;
      hp[lane] = f2bf(x1[slot] * r * (isg ? gg1 : rg1) * silu_f(g1[slot]));
      hp[64 + lane] = f2bf(x2[slot] * r * (isg ? gg2 : rg2) * silu_f(g2[slot]));
    }
  }
}

__device__ __forceinline__ void fixup_phase(KP p, int wv, int l, bool last) {
  p = relaunder(p);
  const float* cw = p->conv_w + (size_t)l * 3 * DFF;
  const int total = 72 * 2 * DFF;
  const int tid_ = otid(wv);
  for (int i = blockIdx.x * NTHR + tid_; i < total; i += gridDim.x * NTHR) {
    const int f = i % DFF, pe = i / DFF, pm = pe >> 1, e = pe & 1, k = pm % 9;
    if (k == 0) continue;
    if (e == 0 && k == 1) continue;
    if (e == 1 && k == 8) continue;
    const float* hb = p->HB + (((size_t)(pm * 2 + e)) * DFF + f) * 2;
    const float part = hb[0], v = hb[1];
    float cvv; int row;
    if (e == 0) { const float an = p->HA[((size_t)((pm - 1) * 2 + 1)) * DFF + f]; cvv = part + an * cw[f]; row = pm * 256; }
    else { const float an = p->HA[((size_t)((pm + 1) * 2 + 0)) * DFF + f]; cvv = part + an * cw[2 * DFF + f]; row = pm * 256 + 255; }
    p->U[(size_t)row * DFF + f] = f2bf(silu_f(cvv) * v);
  }
}

__device__ __forceinline__ void final_phase(KP p, int wv) {
  p = relaunder(p);
  const int tid_ = otid(wv); const int wid = wv, lane = tid_ & 63;
  for (int r0 = (blockIdx.x * 8 + wid) * 2; r0 < NB * SEQ; r0 += gridDim.x * 16) {
    f32x4 v[2][8];
#pragma unroll
    for (int q = 0; q < 2; ++q) { const int rr = r0 + q, b = rr / SEQ, t = rr % SEQ; const float* xr = p->X + (size_t)(b * RPB + CTX + t) * DM;
#pragma unroll
      for (int i = 0; i < 8; ++i) v[q][i] = *(const f32x4*)(xr + i * 256 + lane * 4); }
#pragma unroll
    for (int q = 0; q < 2; ++q) {
      float ss = 0.f;
#pragma unroll
      for (int i = 0; i < 8; ++i) ss += v[q][i][0] * v[q][i][0] + v[q][i][1] * v[q][i][1] + v[q][i][2] * v[q][i][2] + v[q][i][3] * v[q][i][3];
      ss = wave_sum(ss);
      const float r = rsqrtf(ss * (1.f / DM) + EPS);
#pragma unroll
      for (int i = 0; i < 8; ++i) { const int col = i * 256 + lane * 4; const f32x4 gg = *(const f32x4*)(p->final_norm_g + col);
        __builtin_nontemporal_store(v[q][i] * r * gg, (f32x4*)(p->out + (size_t)(r0 + q) * DM + col)); }
    }
  }
}

#define GSYNC() xcd_barrier(xbar)
template <int l>
__device__ __forceinline__ void layer_body(KP p, int wv, char* shm, cg::grid_group& grid, const XcdBarrier& xbar, volatile LAS unsigned* bcw) {
  constexpr bool last = (l == 1);
  const int G = gridDim.x;

    if (l == 0) {
      for (int u = blockIdx.x; u < 768; u += G) gemv9_unit<0>(p, wv, u, 0, shm);
      conv_phase(p, wv, 0, shm, 0, CV_IN + CV_OUT, 0);
      if (p->out == nullptr) grid.sync();
      GSYNC();
      norm_phase(p, wv, 0, 0, true, false);
      GSYNC();
    }
    for (int i = blockIdx.x; i < 72 * 21; i += G) { int pm, pn, qm = -1, qn = -1; tile_map(i, 72, 21, pm, pn, 2); if (i + G < 72 * 21) tile_map(i + G, 72, 21, qm, qn, 2);
      const bool pre = i != (int)blockIdx.x; const int nr = qm < 0 ? -1 : qm * 256, nc = qn * 256;
      if (l == 0) { EpiBf16<false> epi{p->Z, ZLD, nullptr, nullptr}; gemm_tile(p->H, DM, p->Wt_in, DM, DM, pm * 256, pn * 256, shm, epi, wv, pre, nr, nc); }
      else { EpiBf16<true> epi{p->Z, ZLD, (const float*)(p->ctl + SSQ_WORD) + (size_t)2 * NROWS, p->sWin + (size_t)((pm % 9) == 0 ? 8 : pm / 9) * ZLD}; gemm_tile(p->H, DM, p->Wt_in, DM, DM, pm * 256, pn * 256, shm, epi, wv, pre, nr, nc); } }
    GSYNC();
    prep_phase(p, wv, l, shm);
    if (l == 1) conv_phase(p, wv, 1, shm, CV_IN + CV_OUT + CV_UP, CV_TOTAL, 0);
    GSYNC();
    {
      mix1_phase(p, wv, l, last, shm, bcw);
      GSYNC();
    }
    {
      mix2_phase(p, wv, l, last);
      GSYNC();
    }
    { const int nM = last ? 64 : 72;
      for (int i = blockIdx.x; i < nM * 8; i += G) { int pm, pn, qm = -1, qn = -1; tile_map(i, nM, 8, pm, pn); if (last) pm = (pm >> 3) * 9 + 1 + (pm & 7);
        if (i + G < nM * 8) { tile_map(i + G, nM, 8, qm, qn); if (last) qm = (qm >> 3) * 9 + 1 + (qm & 7); }
        const bool pre = i != (int)blockIdx.x; const int nr = qm < 0 ? -1 : qm * 256, nc = qn * 256;
        const int b = pm / 9; const bool isctx = (pm % 9) == 0;
        const int mr = l * 9 + (isctx ? 8 : b);
        EpiOut epi;
        if (l == 0) { epi.base = isctx ? p->ctx + (size_t)b * CTX * DM : p->x + (size_t)b * SEQ * DM; epi.base_row0 = isctx ? (long)b * RPB : (long)b * RPB + CTX; }
        else { epi.base = p->X; epi.base_row0 = 0; }
        epi.X = p->X; epi.gate = p->mod + (size_t)mr * NMOD + 2 * DM; epi.n2g = p->norm2_g + l * DM; epi.scl = p->mod + (size_t)mr * NMOD + 4 * DM;
        epi.H2 = (bf16_t*)p->RO; epi.ssq = (float*)(p->ctl + SSQ_WORD) + (size_t)l * NROWS;
        gemm_tile(p->H, DM, p->Wt_out, DM, DM, pm * 256, pn * 256, shm, epi, wv, pre, nr, nc); }
      if (l == 0) conv_phase(p, wv, 0, shm, CV_IN + CV_OUT, CV_TOTAL, (nM * 8) % G ? (nM * 8) % G : 0); }
    GSYNC();
    {
      const int nM = last ? 64 : 72;
      for (int i = blockIdx.x; i < nM * 44; i += G) { int pm, pn; tile_map(i, nM, 44, pm, pn); if (last) pm = (pm >> 3) * 9 + 1 + (pm & 7);
        const int mr = l * 9 + ((pm % 9) == 0 ? 8 : pm / 9);
        EpiUp epi{p->conv_w + (size_t)l * 3 * DFF, p->conv_b + (size_t)l * DFF, p->U, p->HA, p->HB, pm, pn, (const float*)(p->ctl + SSQ_WORD) + (size_t)l * NROWS, p->sW + (size_t)mr * (2 * DFF)};
        gemm_tile((const bf16_t*)p->RO, DM, p->Wt_up, DM, DM, pm * 256, pn * 256, shm, epi, wv); }
      GSYNC();
    }
    {
      fixup_phase(p, wv, l, last);
      GSYNC();
    }
    { const int nM = last ? 64 : 72;
      for (int i = blockIdx.x; i < nM * 8; i += G) { int pm, pn, qm = -1, qn = -1; tile_map(i, nM, 8, pm, pn, 4); if (last) pm = (pm >> 3) * 9 + 1 + (pm & 7);
        if (i + G < nM * 8) { tile_map(i + G, nM, 8, qm, qn, 4); if (last) qm = (qm >> 3) * 9 + 1 + (qm & 7); }
        const bool pre = i != (int)blockIdx.x; const int nr = qm < 0 ? -1 : qm * 256, nc = qn * 256;
        const int b = pm / 9; const bool isctx = (pm % 9) == 0;
        if (l == 0) {
          EpiOut epi; epi.base = p->X; epi.base_row0 = 0; epi.X = p->X; epi.gate = p->mod + (size_t)(isctx ? 8 : b) * NMOD + 5 * DM;
          epi.n2g = p->norm1_g + DM; epi.scl = p->mod + (size_t)(9 + (isctx ? 8 : b)) * NMOD + 1 * DM; epi.H2 = p->H; epi.ssq = (float*)(p->ctl + SSQ_WORD) + (size_t)2 * NROWS;
          gemm_tile(p->U, DFF, p->Wt_down, DFF, DFF, pm * 256, pn * 256, shm, epi, wv, pre, nr, nc);
        } else {
          EpiRes epi; epi.base = p->X; epi.base_row0 = 0; epi.X = p->X; epi.gate = p->mod + (size_t)(l * 9 + (isctx ? 8 : b)) * NMOD + 5 * DM;
          gemm_tile(p->U, DFF, p->Wt_down, DFF, DFF, pm * 256, pn * 256, shm, epi, wv, pre, nr, nc);
        } }
      if (l == 0) conv_phase(p, wv, 1, shm, 0, CV_IN + CV_OUT + CV_UP, (nM * 8) % G ? (nM * 8) % G : 0); }
    GSYNC();
  }

__global__ void __launch_bounds__(NTHR) mega(Params pk) {
  extern __shared__ __attribute__((aligned(16))) char shm[];
  __shared__ uint4 xb_words;
  cg::grid_group grid = cg::this_grid();
  KP p = relaunder((KP)__builtin_amdgcn_kernarg_segment_ptr());
  const int wv = __builtin_amdgcn_readfirstlane((int)(threadIdx.x >> 6));
  if (threadIdx.x == 0) xb_words = make_uint4(0u, 0u, 0u, 0u);
  __syncthreads();
  const XcdBarrier xbar = xcd_barrier_post(p->ctl, (volatile LAS unsigned*)&xb_words);
#define GSYNC() xcd_barrier(xbar)
  layer_body<0>(p, wv, shm, grid, xbar, (volatile LAS unsigned*)&xb_words);
  layer_body<1>(p, wv, shm, grid, xbar, (volatile LAS unsigned*)&xb_words);
  final_phase(p, wv);
}

static inline size_t al256(size_t x) { return (x + 255) & ~(size_t)255; }
extern "C" void kernel_launch(void* const* d_in, const int* in_sizes, int n_in, void* d_out, int out_size, void* d_ws, size_t ws_size, hipStream_t stream) {
  static int grid_blocks = 0;
  if (!grid_blocks) {
    int dev = 0, cus = 0, per_cu = 0;
    hipGetDevice(&dev);
    hipDeviceGetAttribute(&cus, hipDeviceAttributeMultiprocessorCount, dev);
    if (hipFuncSetAttribute((const void*)mega, hipFuncAttributeMaxDynamicSharedMemorySize, SHM_BYTES) != hipSuccess) fprintf(stderr, "hipFuncSetAttribute failed\n");
    hipOccupancyMaxActiveBlocksPerMultiprocessor(&per_cu, mega, NTHR, SHM_BYTES);
    if (per_cu < 1) { fprintf(stderr, "occupancy query returned %d\n", per_cu); per_cu = 1; }
    if (per_cu > 1) per_cu = 1;
    grid_blocks = cus * per_cu;
  }
  Params p{};
  const float* const* in = (const float* const*)d_in;
  p.x = in[0]; p.c = in[1]; p.ctx = in[2]; p.c_ctx = in[3]; p.ada_w = in[4]; p.ada_b = in[5]; p.norm1_g = in[6]; p.w_in = in[7];
  p.q_norm_g = in[8]; p.k_norm_g = in[9]; p.ret_log_decay = in[10]; p.ret_norm_g = in[11]; p.gla_gate_up = in[12]; p.gla_gate_b = in[13];
  p.gla_norm_g = in[14]; p.w_out = in[15]; p.norm2_g = in[16]; p.w_up = in[17]; p.conv_w = in[18]; p.conv_b = in[19]; p.w_down = in[20]; p.final_norm_g = in[21];
  p.out = (float*)d_out;
  char* w = (char*)d_ws; size_t off = 0;
  auto take = [&](size_t bytes) { char* r = w + off; off = al256(off + bytes); return r; };
  p.Wt_in = (bf16_t*)take((size_t)ZLD * DM * 2);
  p.Wt_out = (bf16_t*)take((size_t)DM * DM * 2);
  p.Wt_up = (bf16_t*)take((size_t)2 * DFF * DM * 2);
  p.Wt_down = (bf16_t*)take((size_t)DM * DFF * 2);
  p.mod = (float*)take((size_t)2 * 9 * NMOD * 4);
  p.X = (float*)take((size_t)NROWS * DM * 4);
  p.H = (bf16_t*)take((size_t)NROWS * DM * 2);
  p.HA = (float*)take((size_t)72 * 2 * DFF * 4);
  p.HB = (float*)take((size_t)72 * 2 * DFF * 2 * 4);
  p.ctl = (unsigned*)take((size_t)CTL_WORDS * 4);
  p.sW = (float*)take((size_t)2 * 9 * 2 * DFF * 4);
  p.sWin = (float*)take((size_t)9 * ZLD * 4);
  p.Kc = (bf16_t*)take((size_t)NB * 2 * RPB * 128 * 2);
  p.Vc = (bf16_t*)take((size_t)NB * 2 * RPB * 128 * 2);
  const size_t roff = off;
  p.Z = (bf16_t*)take((size_t)NROWS * ZLD * 2);
  p.GQt = (bf16_t*)take((size_t)2 * NROWS * 256 * 2);
  p.GKt = (bf16_t*)take((size_t)2 * NROWS * 256 * 2);
  p.Eend = (float*)take((size_t)2 * (NROWS / 64) * 256 * 4);
  p.RO = (bf16_t*)take((size_t)2 * NROWS * 512 * 2);
  p.GO = (bf16_t*)take((size_t)2 * NROWS * 512 * 2);
  p.U = (bf16_t*)(w + roff);
  if (off > ws_size) { fprintf(stderr, "workspace too small: need %zu have %zu\n", off, ws_size); return; }
  if (hipMemsetAsync(p.ctl, 0, (size_t)CTL_WORDS * 4, stream) != hipSuccess) fprintf(stderr, "memset failed\n");
  void* args[] = {&p};
  hipError_t e = hipLaunchCooperativeKernel((void*)mega, dim3(grid_blocks), dim3(NTHR), args, SHM_BYTES, stream);
  if (e != hipSuccess) fprintf(stderr, "cooperative launch failed: %s (grid %d)\n", hipGetErrorString(e), grid_blocks);
}
```

```cpp
#include <hip/hip_runtime.h>
#include <hip/hip_bf16.h>
#include <hip/hip_cooperative_groups.h>
#include <cstdio>
#include <cstdint>
namespace cg = cooperative_groups;

#ifndef PROBE
#define PROBE 0
#endif
#define REPS(bit) (((PROBE) >> (bit)) & 1 ? 2 : 1)
typedef unsigned short bf16_t;
using bf16x8 = __attribute__((ext_vector_type(8))) short;
using s16x4  = __attribute__((ext_vector_type(4))) short;
using f32x4  = __attribute__((ext_vector_type(4))) float;
using f32x16 = __attribute__((ext_vector_type(16))) float;
using u32x4  = __attribute__((ext_vector_type(4))) unsigned;
using u32x2  = __attribute__((ext_vector_type(2))) unsigned;

constexpr int NB = 8, SEQ = 2048, CTX = 256, DM = 2048, DFF = 5632, NIN = 5152;
constexpr int RPB = SEQ + CTX;
constexpr int NROWS = NB * RPB;
constexpr int ZLD = 5376;
constexpr int NMOD = 6 * DM;
constexpr int C_AQ = 0, C_AK = 1024, C_AV = 1280, C_RQ = 1536, C_RK = 2048, C_RV = 2560, C_RG = 3072,
              C_GQ = 3584, C_GK = 3840, C_GV = 4096, C_GR = 4608, C_GA = 5120;
constexpr float EPS = 1e-6f;
constexpr int NTHR = 512;
constexpr int SHM_BYTES = 139264;

struct Params {
  const float *x, *c, *ctx, *c_ctx, *ada_w, *ada_b, *norm1_g, *w_in, *q_norm_g, *k_norm_g, *ret_log_decay, *ret_norm_g,
      *gla_gate_up, *gla_gate_b, *gla_norm_g, *w_out, *norm2_g, *w_up, *conv_w, *conv_b, *w_down, *final_norm_g;
  float* out;
  bf16_t *Wt_in, *Wt_out, *Wt_up, *Wt_down;
  float* mod;
  float* X;
  bf16_t* H;
  bf16_t* Z;
  bf16_t* U;
  bf16_t* GQt;
  bf16_t* GKt;
  float* Eend;
  bf16_t* RO;
  bf16_t* GO;
  float* HA;
  float* HB;
  unsigned* ctl;
  float* sW;
  float* sWin;
  bf16_t* Kc;
  bf16_t* Vc;
};

typedef const __attribute__((address_space(4))) Params* KP;
__device__ __forceinline__ KP relaunder(KP p) { asm volatile("" : "+s"(p)); return p; }

__device__ __forceinline__ float bf2f(bf16_t h) { return __uint_as_float((unsigned)h << 16); }
__device__ __forceinline__ bf16_t f2bf(float f) { unsigned u = __float_as_uint(f); u += 0x7fffu + ((u >> 16) & 1u); return (bf16_t)(u >> 16); }
__device__ __forceinline__ unsigned cvtpk_asm(float lo, float hi) { unsigned r; asm volatile("v_cvt_pk_bf16_f32 %0, %1, %2" : "=v"(r) : "v"(lo), "v"(hi)); return r; }
typedef __bf16 bf16v2_t __attribute__((ext_vector_type(2)));
typedef float f32v2_t __attribute__((ext_vector_type(2)));
__device__ __forceinline__ unsigned cvtpk(float lo, float hi) { const f32v2_t v = {lo, hi}; const bf16v2_t b = __builtin_convertvector(v, bf16v2_t); return __builtin_bit_cast(unsigned, b); }
template <int X> __device__ __forceinline__ float swz_xor(float v) { return __int_as_float(__builtin_amdgcn_ds_swizzle(__float_as_int(v), (X << 10) | 0x1F)); }
__device__ __forceinline__ float wave_sum(float v) {
  v += swz_xor<16>(v); v += swz_xor<8>(v); v += swz_xor<4>(v); v += swz_xor<2>(v); v += swz_xor<1>(v);
  auto rr = __builtin_amdgcn_permlane32_swap(__float_as_uint(v), __float_as_uint(v), false, false);
  return __uint_as_float(rr[0]) + __uint_as_float(rr[1]);
}
__device__ __forceinline__ int otid(int wv) { unsigned z = 0u; asm volatile("" : "+v"(z)); return (wv << 6) | (int)__builtin_amdgcn_mbcnt_hi(~0u, __builtin_amdgcn_mbcnt_lo(~0u, z)); }
__device__ __forceinline__ float silu_f(float x) { return x * __builtin_amdgcn_rcpf(1.f + __builtin_amdgcn_exp2f(-1.4426950408889634f * x)); }
__device__ __forceinline__ float fexp(float x) { return __builtin_amdgcn_exp2f(1.4426950408889634f * x); }

#define XB_TMO      128
#define XB_XCNT(j)  (256  + 64 * (j))
#define XB_XSUB(j)  (1280 + 64 * (j))
#define XB_XGEN(j)  (2304 + 64 * (j))
#define XB_TOP      3328
#define XB_TOPGEN   3392
#define XCD_BAR_WORDS 3456
#define WQ_WORD(l, x) (XCD_BAR_WORDS + 64 * ((l) * 8 + (x)))
#define SSQ_WORD (XCD_BAR_WORDS + 64 * 16)
#define CTL_WORDS (SSQ_WORD + 3 * 18432)
#define XB_SPIN_CAP (1u << 22)
#define LAS __attribute__((address_space(3)))
__device__ __forceinline__ unsigned xb_ld(unsigned* p)              { return __hip_atomic_load(p, __ATOMIC_RELAXED, __HIP_MEMORY_SCOPE_AGENT); }
__device__ __forceinline__ unsigned xb_add(unsigned* p, unsigned v) { return __hip_atomic_fetch_add(p, v, __ATOMIC_RELAXED, __HIP_MEMORY_SCOPE_AGENT); }
__device__ __forceinline__ unsigned xb_xcc_id() { return (unsigned)__builtin_amdgcn_s_getreg((3 << 11) | 20) & 0xFu; }
#define XB_SPIN(cond, bar) do { unsigned _sp = 0; while (cond) { __builtin_amdgcn_s_sleep(1); \
    if ((++_sp & 255u) == 0u) { if (xb_ld(&(bar)[XB_TMO])) break; if (_sp > XB_SPIN_CAP) { atomicAdd(&(bar)[XB_TMO], 1u); break; } } } } while (0)
struct XcdBarrier { unsigned* bar; unsigned x; volatile LAS unsigned* st; };
__device__ __forceinline__ XcdBarrier xcd_barrier_post(unsigned* bar, volatile LAS unsigned* st) {
  XcdBarrier b; b.bar = bar; b.x = xb_xcc_id(); b.st = st;
  if (threadIdx.x == 0) (void)xb_add(&bar[XB_XCNT(b.x)], 1u);
  return b;
}
__device__ __forceinline__ void xcd_barrier_complete(unsigned* bar, unsigned x, unsigned& nloc, unsigned& nx) {
  const unsigned G = gridDim.x * gridDim.y * gridDim.z;
  unsigned sum, cnt, mine, sp = 0u;
  for (;;) {
    sum = 0u; cnt = 0u; mine = 0u;
#pragma unroll
    for (unsigned j = 0; j < 16; ++j) { const unsigned c = xb_ld(&bar[XB_XCNT(j)]); sum += c; cnt += (c > 0u) ? 1u : 0u; mine = (j == x) ? c : mine; }
    if (sum == G) break;
    __builtin_amdgcn_s_sleep(1);
    if ((++sp & 255u) == 0u) { if (xb_ld(&bar[XB_TMO])) break; if (sp > XB_SPIN_CAP) { atomicAdd(&bar[XB_TMO], 1u); break; } }
  }
  nloc = mine > 0u ? mine : 1u; nx = cnt > 0u ? cnt : 1u;
}
__device__ __forceinline__ void xcd_barrier(const XcdBarrier& b) {
  asm volatile("s_waitcnt vmcnt(0)" ::: "memory");
  __syncthreads();
  if (threadIdx.x == 0) {
    unsigned* bar = b.bar;
    __builtin_amdgcn_s_waitcnt(0);
    unsigned nloc = b.st[0], nx = b.st[1];
    if (nloc == 0u) { xcd_barrier_complete(bar, b.x, nloc, nx); b.st[0] = nloc; b.st[1] = nx; }
    const unsigned old = xb_add(&bar[XB_XSUB(b.x)], 1u);
    const unsigned gen = old / nloc;
    if (old + 1u == (gen + 1u) * nloc) {
      __builtin_amdgcn_fence(__ATOMIC_RELEASE, "agent");
      asm volatile("s_waitcnt vmcnt(0)" ::: "memory");
      const unsigned og = xb_add(&bar[XB_TOP], 1u);
      const unsigned tg = og / nx;
      if (og + 1u == (tg + 1u) * nx) xb_add(&bar[XB_TOPGEN], 1u);
      else XB_SPIN(xb_ld(&bar[XB_TOPGEN]) == tg, bar);
      __builtin_amdgcn_fence(__ATOMIC_ACQUIRE, "agent");
      xb_add(&bar[XB_XGEN(b.x)], 1u);
      asm volatile("s_waitcnt vmcnt(0)" ::: "memory");
    } else {
      XB_SPIN(xb_ld(&bar[XB_XGEN(b.x)]) == gen, bar);
      __builtin_amdgcn_fence(__ATOMIC_ACQUIRE, "agent");
      asm volatile("s_waitcnt vmcnt(0)" ::: "memory");
    }
  }
  __syncthreads();
}

constexpr int CV_IN = 42 * 32, CV_OUT = 16 * 32, CV_UP = 88 * 32, CV_DOWN = 16 * 88, CV_TOTAL = CV_IN + CV_OUT + CV_UP + CV_DOWN;
struct CvUnit { const float* src; bf16_t* dst; int K, N, k0, n0, perm; };
__device__ __forceinline__ CvUnit cv_decode(KP p, int l, int u) {
  CvUnit c;
  if (u < CV_IN) { c.src = p->w_in + (size_t)l * DM * NIN; c.dst = p->Wt_in; c.K = DM; c.N = NIN; c.k0 = (u / 42) * 64; c.n0 = (u % 42) * 128; c.perm = 0; }
  else if (u < CV_IN + CV_OUT) { const int v = u - CV_IN; c.src = p->w_out + (size_t)l * DM * DM; c.dst = p->Wt_out; c.K = DM; c.N = DM; c.k0 = (v / 16) * 64; c.n0 = (v % 16) * 128; c.perm = 0; }
  else if (u < CV_IN + CV_OUT + CV_UP) { const int v = u - CV_IN - CV_OUT; c.src = p->w_up + (size_t)l * DM * 2 * DFF; c.dst = p->Wt_up; c.K = DM; c.N = 2 * DFF; c.k0 = (v / 88) * 64; c.n0 = (v % 88) * 128; c.perm = 1; }
  else { const int v = u - CV_IN - CV_OUT - CV_UP; c.src = p->w_down + (size_t)l * DFF * DM; c.dst = p->Wt_down; c.K = DFF; c.N = DM; c.k0 = (v / 16) * 64; c.n0 = (v % 16) * 128; c.perm = 0; }
  return c;
}
__device__ __forceinline__ void conv_phase(KP p, int wv, int l, char* lds, const int u_lo, const int u_hi, const int bstart) {
  p = relaunder(p);
  float* tile = (float*)lds;
  const int tid = otid(wv);
  const int lk = tid >> 5, ln = (tid & 31) * 4;
  const int sn = tid >> 2, sk = (tid & 3) * 16;
  if ((int)blockIdx.x < bstart) return;
  const int ustride = (int)gridDim.x - bstart;
  int u = u_lo + (int)blockIdx.x - bstart;
  if (u >= u_hi) return;
  CvUnit c = cv_decode(p, l, u);
  f32x4 r[4];
#define CVLOAD() do { _Pragma("unroll") for (int i = 0; i < 4; ++i) { r[i] = (f32x4){0.f, 0.f, 0.f, 0.f}; \
    if (c.n0 + ln < c.N) r[i] = __builtin_nontemporal_load((const f32x4*)(c.src + (size_t)(c.k0 + lk + 16 * i) * c.N + c.n0 + ln)); } } while (0)
  CVLOAD();
  for (;;) {
#pragma unroll
    for (int i = 0; i < 4; ++i) {
#pragma unroll
      for (int j = 0; j < 4; ++j) tile[(lk + 16 * i) * 129 + ln + j] = r[i][j];
    }
    const CvUnit cur = c;
    const int un = u + ustride; const bool more = un < u_hi;
    if (more) { c = cv_decode(p, l, un); CVLOAD(); }
    __syncthreads();
    {
      int drow = cur.n0 + sn;
      if (cur.perm) { const bool isv = cur.n0 >= DFF; const int j0 = isv ? cur.n0 - DFF : cur.n0; drow = (j0 >> 7) * 256 + (isv ? 128 : 0) + sn; }
      u32x4 w0, w1;
#pragma unroll
      for (int q = 0; q < 4; ++q) w0[q] = cvtpk(tile[(sk + 2 * q) * 129 + sn], tile[(sk + 2 * q + 1) * 129 + sn]);
#pragma unroll
      for (int q = 0; q < 4; ++q) w1[q] = cvtpk(tile[(sk + 8 + 2 * q) * 129 + sn], tile[(sk + 8 + 2 * q + 1) * 129 + sn]);
      bf16_t* dp = cur.dst + (size_t)drow * cur.K + cur.k0 + sk;
      *(u32x4*)dp = w0; *(u32x4*)(dp + 8) = w1;
    }
    __syncthreads();
    if (!more) break;
    u = un;
  }
#undef CVLOAD
}

template <int MODE>
__device__ __forceinline__ void gemv9_unit(KP p, int wv, int u, int l1, char* lds) {
  p = relaunder(p);
  const int tid = otid(wv);
  const int l = MODE == 0 ? u / 384 : l1, n0 = (MODE == 0 ? (u % 384) : u) * 32;
  const int NW_ = MODE == 0 ? NMOD : MODE == 1 ? 2 * DFF : NIN;
  if (MODE == 2 && n0 >= NIN) { if (tid < 288) p->sWin[(size_t)(tid >> 5) * ZLD + n0 + (tid & 31)] = 0.f; return; }
  float* sc = (float*)lds;
  for (int i = tid; i < 9 * 2048; i += NTHR) { const int r = i >> 11, k = i & 2047;
    if (MODE == 0) { const float v = (r < 8) ? p->c[r * 2048 + k] : p->c_ctx[k]; sc[i] = silu_f(v); }
    else sc[i] = p->mod[(size_t)(l * 9 + r) * NMOD + (MODE == 1 ? 3 : 0) * DM + k]; }
  __syncthreads();
  const int kg = tid >> 3, cq = tid & 7;
  const float* w = (MODE == 0 ? p->ada_w + (size_t)l * DM * NMOD : MODE == 1 ? p->w_up + (size_t)l * DM * 2 * DFF : p->w_in + (size_t)l * DM * NIN) + (size_t)(kg * 32) * NW_ + n0 + cq * 4;
  f32x4 acc[9];
#pragma unroll
  for (int r = 0; r < 9; ++r) acc[r] = (f32x4){0.f, 0.f, 0.f, 0.f};
#pragma unroll
  for (int kb = 0; kb < 32; kb += 16) {
    f32x4 wv4[16];
#pragma unroll
    for (int j = 0; j < 16; ++j) wv4[j] = __builtin_nontemporal_load((const f32x4*)(w + (size_t)(kb + j) * NW_));
#pragma unroll
    for (int r = 0; r < 9; ++r) {
#pragma unroll
      for (int j4 = 0; j4 < 4; ++j4) {
        const f32x4 s = *(const f32x4*)&sc[r * 2048 + kg * 32 + kb + j4 * 4];
        acc[r] += wv4[j4 * 4 + 0] * s[0] + wv4[j4 * 4 + 1] * s[1] + wv4[j4 * 4 + 2] * s[2] + wv4[j4 * 4 + 3] * s[3];
      }
    }
  }
  __syncthreads();
  float* red = sc;
#pragma unroll
  for (int r = 0; r < 9; ++r) *(f32x4*)&red[(kg * 9 + r) * 32 + cq * 4] = acc[r];
  __syncthreads();
  if (tid < 288) {
    const int r = tid >> 5, cc = tid & 31; float s = MODE == 0 ? p->ada_b[l * NMOD + n0 + cc] : 0.f;
#pragma unroll 8
    for (int g = 0; g < 64; ++g) s += red[(g * 9 + r) * 32 + cc];
    if (MODE == 0) p->mod[(size_t)(l * 9 + r) * NMOD + n0 + cc] = s;
    else if (MODE == 2) p->sWin[(size_t)r * ZLD + n0 + cc] = s;
    else { const int n = n0 + cc, j = n < DFF ? n : n - DFF; p->sW[(size_t)(l * 9 + r) * (2 * DFF) + (j >> 7) * 256 + (n < DFF ? 0 : 128) + (j & 127)] = s; }
  }
  __syncthreads();
}

__device__ __forceinline__ void norm_phase(KP p, int wv, int l, int which, bool from_inputs, bool skip_ctx) {
  p = relaunder(p);
  const int tid_ = otid(wv); const int wid = wv, lane = tid_ & 63;
  const float* g = (which ? p->norm2_g : p->norm1_g) + l * DM;
  for (int row0 = (blockIdx.x * 8 + wid) * 2; row0 < NROWS; row0 += gridDim.x * 16) {
    const float* xr[2]; const float* mrow[2];
#pragma unroll
    for (int q = 0; q < 2; ++q) { const int row = row0 + q, b = row / RPB, rb = row % RPB; const bool isctx = rb < CTX;
      xr[q] = from_inputs ? (isctx ? p->ctx + (size_t)(b * CTX + rb) * DM : p->x + (size_t)(b * SEQ + rb - CTX) * DM) : p->X + (size_t)row * DM;
      mrow[q] = p->mod + (size_t)(l * 9 + (isctx ? 8 : b)) * NMOD + (which ? 3 : 0) * DM; }
    f32x4 v[2][8];
#pragma unroll
    for (int q = 0; q < 2; ++q)
#pragma unroll
      for (int i = 0; i < 8; ++i) v[q][i] = *(const f32x4*)(xr[q] + i * 256 + lane * 4);
#pragma unroll
    for (int q = 0; q < 2; ++q) {
      const int row = row0 + q;
      if (skip_ctx && (row % RPB) < CTX) continue;
      float ss = 0.f;
#pragma unroll
      for (int i = 0; i < 8; ++i) ss += v[q][i][0] * v[q][i][0] + v[q][i][1] * v[q][i][1] + v[q][i][2] * v[q][i][2] + v[q][i][3] * v[q][i][3];
      ss = wave_sum(ss);
      const float r = rsqrtf(ss * (1.f / DM) + EPS);
#pragma unroll
      for (int i = 0; i < 8; ++i) {
        const int col = i * 256 + lane * 4;
        const f32x4 gg = *(const f32x4*)(g + col), sh = *(const f32x4*)(mrow[q] + col), sc = *(const f32x4*)(mrow[q] + DM + col);
        const f32x4 o = (v[q][i] * r * gg) * (sc + 1.f) + sh;
        u32x2 w; w[0] = cvtpk(o[0], o[1]); w[1] = cvtpk(o[2], o[3]);
        *(u32x2*)(p->H + (size_t)row * DM + col) = w;
      }
    }
  }
}

namespace g8 {
constexpr int BM = 256, BK = 64, HALF = 128, HT = HALF * BK;
__device__ __forceinline__ int lds_byte(int r, int c) { const int st = (r >> 4) * 2 + (c >> 5), rr = r & 15, cc = c & 31, ob = rr * 64 + cc * 2; return st * 1024 + (ob ^ (((ob >> 9) & 1) << 5)); }
__device__ __forceinline__ void stage_rc(int b, int& R, int& C) { const int st = b / 1024, sb = b % 1024, swz = sb ^ (((sb >> 9) & 1) << 5); R = (st >> 1) * 16 + swz / 64; C = (st & 1) * 32 + (swz % 64) / 2; }
}
typedef __attribute__((address_space(3))) unsigned lds_u32;

template <class Epi>
__device__ __forceinline__ void gemm_tile(const bf16_t* __restrict__ A, const int lda, const bf16_t* __restrict__ Bt, const int ldb, const int K,
                                          const int brow, const int bcol, char* shmc, Epi& epi, const int wv, const bool pre = false, const int nbrow = -1, const int nbcol = -1) {
  using namespace g8;
  typedef __attribute__((address_space(3))) unsigned char lds_u8;
  lds_u8* lds = (lds_u8*)shmc;
  const int tid = otid(wv);
  const int wid = wv, lane = tid & 63, wr = wid >> 2, wc = wid & 3, fr = lane & 15, fq = lane >> 4;
  constexpr int HTB = HT * 2;
  unsigned voffA[2], voffB[2];
#pragma unroll
  for (int i = 0; i < 2; ++i) { int R, C; stage_rc(tid * 16 + i * 8192, R, C); voffA[i] = (unsigned)(R * lda + C) * 2u; voffB[i] = (unsigned)(R * ldb + C) * 2u; }
  const size_t kstep = (size_t)(BK * 2);
  const size_t hstepA = (size_t)HALF * lda * 2, hstepB = (size_t)HALF * ldb * 2;
  const unsigned ldsw = (unsigned)wid * 1024u;
  const int aoff = lds_byte(wr * 64 + fr, fq * 8), boff = lds_byte(wc * 32 + fr, fq * 8);
  const char* cA = (const char*)A + (size_t)brow * lda * 2; const char* cB = (const char*)Bt + (size_t)bcol * ldb * 2;
#define SA(b, h) (((b) * 2 + (h)) * HTB)
#define SB(b, h) ((4 + (b) * 2 + (h)) * HTB)
#define STAGE(bufoff, gbase, voff) do { _Pragma("unroll") for (int _i = 0; _i < 2; ++_i) \
    __builtin_amdgcn_global_load_lds((const unsigned*)((const char*)(gbase) + (voff)[_i]), (lds_u32*)(lds + (bufoff) + ldsw + _i * 8192), 16, 0, 0); } while (0)
#define LDA(dst, b, h) do { _Pragma("unroll") for (int m = 0; m < 4; ++m) _Pragma("unroll") for (int k = 0; k < 2; ++k) dst[m][k] = *(const __attribute__((address_space(3))) bf16x8*)(lds + SA(b, h) + aoff + m * 2048 + k * 1024); } while (0)
#define LDB(dst, b, h) do { _Pragma("unroll") for (int n = 0; n < 2; ++n) _Pragma("unroll") for (int k = 0; k < 2; ++k) dst[n][k] = *(const __attribute__((address_space(3))) bf16x8*)(lds + SB(b, h) + boff + n * 2048 + k * 1024); } while (0)
#define MMA(ai, bj, At_, Bt_) do { __builtin_amdgcn_s_setprio(1); _Pragma("unroll") for (int m = 0; m < 4; ++m) _Pragma("unroll") for (int n = 0; n < 2; ++n) _Pragma("unroll") for (int k = 0; k < 2; ++k) \
      acc[ai][bj][m][n] = __builtin_amdgcn_mfma_f32_16x16x32_bf16(Bt_[n][k], At_[m][k], acc[ai][bj][m][n], 0, 0, 0); __builtin_amdgcn_s_setprio(0); } while (0)
#define WAIT_V(n) asm volatile("s_waitcnt vmcnt(" #n ")" ::: "memory")
#define WAIT_L(n) asm volatile("s_waitcnt lgkmcnt(" #n ")" ::: "memory")
#define BAR __builtin_amdgcn_s_barrier()
#define SCHED __builtin_amdgcn_sched_barrier(0)
  f32x4 acc[2][2][4][2];
#pragma unroll
  for (int a = 0; a < 2; ++a)
#pragma unroll
    for (int b = 0; b < 2; ++b)
#pragma unroll
      for (int m = 0; m < 4; ++m)
#pragma unroll
        for (int n = 0; n < 2; ++n) acc[a][b][m][n] = (f32x4){0.f, 0.f, 0.f, 0.f};
  bf16x8 At[4][2], B0[2][2], B1[2][2];
  const int nt = K / BK;
  if (!pre) { STAGE(SB(0, 0), cB, voffB); STAGE(SA(0, 0), cA, voffA); STAGE(SB(0, 1), cB + hstepB, voffB); STAGE(SA(0, 1), cA + hstepA, voffA); }
  if (wr == 1) BAR;
  WAIT_V(4); BAR;
  STAGE(SB(1, 0), cB + kstep, voffB); STAGE(SA(1, 0), cA + kstep, voffA); STAGE(SB(1, 1), cB + hstepB + kstep, voffB);
  WAIT_V(6); BAR;
  for (int t = 0; t < nt - 2; t += 2) {
    const char* a1 = cA + (size_t)(t + 1) * kstep;
    const char* a2 = cA + (size_t)(t + 2) * kstep; const char* b2 = cB + (size_t)(t + 2) * kstep;
    const char* a3 = a2 + kstep; const char* b3 = b2 + kstep;
    LDB(B0, 0, 0); SCHED; LDA(At, 0, 0); STAGE(SA(1, 1), a1 + hstepA, voffA);
    WAIT_L(8); BAR; WAIT_L(0); MMA(0, 0, At, B0); BAR; SCHED;
    LDB(B1, 0, 1); STAGE(SB(0, 0), b2, voffB);
    BAR; WAIT_L(0); MMA(0, 1, At, B1); BAR;
    LDA(At, 0, 1); STAGE(SA(0, 0), a2, voffA);
    BAR; WAIT_L(0); MMA(1, 0, At, B0); BAR; SCHED;
    STAGE(SB(0, 1), b2 + hstepB, voffB);
    WAIT_V(6); BAR; MMA(1, 1, At, B1); BAR;
    LDB(B0, 1, 0); SCHED; LDA(At, 1, 0); STAGE(SA(0, 1), a2 + hstepA, voffA);
    WAIT_L(8); BAR; WAIT_L(0); MMA(0, 0, At, B0); BAR; SCHED;
    LDB(B1, 1, 1); STAGE(SB(1, 0), b3, voffB);
    BAR; WAIT_L(0); MMA(0, 1, At, B1); BAR;
    LDA(At, 1, 1); STAGE(SA(1, 0), a3, voffA);
    BAR; WAIT_L(0); MMA(1, 0, At, B0); BAR; SCHED;
    STAGE(SB(1, 1), b3 + hstepB, voffB);
    WAIT_V(6); BAR; MMA(1, 1, At, B1); BAR;
  }
  { const char* a1 = cA + (size_t)(nt - 1) * kstep;
    LDB(B0, 0, 0); LDA(At, 0, 0); STAGE(SA(1, 1), a1 + hstepA, voffA);
    BAR; WAIT_L(0); MMA(0, 0, At, B0); BAR;
    LDB(B1, 0, 1); BAR; WAIT_L(0); MMA(0, 1, At, B1); BAR;
    LDA(At, 0, 1); WAIT_V(4); BAR; WAIT_L(0); MMA(1, 0, At, B0); MMA(1, 1, At, B1); BAR; }
  { LDB(B0, 1, 0); LDA(At, 1, 0); WAIT_V(2); BAR; WAIT_L(0); MMA(0, 0, At, B0); BAR;
    LDB(B1, 1, 1); WAIT_V(0); BAR; WAIT_L(0); MMA(0, 1, At, B1); BAR;
    LDA(At, 1, 1); BAR; WAIT_L(0); MMA(1, 0, At, B0); MMA(1, 1, At, B1); BAR; }
  if (wr == 0) BAR;
  __syncthreads();
  __builtin_amdgcn_sched_barrier(0);
  if (nbrow >= 0) { const char* nA = (const char*)A + (size_t)nbrow * lda * 2; const char* nB = (const char*)Bt + (size_t)nbcol * ldb * 2;
    const int t2 = otid(wv); unsigned vA2[2], vB2[2];
#pragma unroll
    for (int i = 0; i < 2; ++i) { int R, C; stage_rc(t2 * 16 + i * 8192, R, C); vA2[i] = (unsigned)(R * lda + C) * 2u; vB2[i] = (unsigned)(R * ldb + C) * 2u; }
    STAGE(SB(0, 0), nB, vB2); STAGE(SA(0, 0), nA, vA2); STAGE(SB(0, 1), nB + hstepB, vB2); STAGE(SA(0, 1), nA + hstepA, vA2); }
  epi(acc, brow, bcol, wr, wc, fr, fq, shmc);
  __syncthreads();
#undef SA
#undef SB
#undef STAGE
#undef LDA
#undef LDB
#undef MMA
}

__device__ __forceinline__ void tile_map(int L, int nM, int nN, int& pm, int& pn, const int WGM = 8) {
  const int nwg = nM * nN; int wgid = L;
  { const int q = nwg / 8, r = nwg % 8, xcd = wgid % 8, off = wgid / 8; wgid = (xcd < r ? xcd * (q + 1) : r * (q + 1) + (xcd - r) * q) + off; }
  const int nig = WGM * nN, gid = wgid / nig, fm = gid * WGM, gsz = (nM - fm) < WGM ? (nM - fm) : WGM;
  pm = fm + ((wgid % nig) % gsz); pn = (wgid % nig) / gsz;
}

template <bool NORM>
struct EpiBf16 {
  bf16_t* O; int ldo; const float* ssq; const float* sWr;
  __device__ __forceinline__ void operator()(f32x4 (&acc)[2][2][4][2], int brow, int bcol, int wr, int wc, int fr, int fq, char*) const {
    if (NORM) {
      float rs[2][4];
#pragma unroll
      for (int ai = 0; ai < 2; ++ai)
#pragma unroll
        for (int m = 0; m < 4; ++m) rs[ai][m] = rsqrtf(ssq[brow + ai * 128 + wr * 64 + m * 16 + fr] * (1.f / DM) + EPS);
#pragma unroll
      for (int bj = 0; bj < 2; ++bj)
#pragma unroll
        for (int n = 0; n < 2; ++n) { const f32x4 sw = *(const f32x4*)(sWr + bcol + bj * 128 + wc * 32 + n * 16 + fq * 4);
#pragma unroll
          for (int ai = 0; ai < 2; ++ai)
#pragma unroll
            for (int m = 0; m < 4; ++m) acc[ai][bj][m][n] = acc[ai][bj][m][n] * rs[ai][m] + sw; }
    }
#pragma unroll
    for (int ai = 0; ai < 2; ++ai)
#pragma unroll
      for (int m = 0; m < 4; ++m) {
        bf16_t* rowp = O + (size_t)(brow + ai * 128 + wr * 64 + m * 16 + fr) * ldo + bcol + wc * 32 + fq * 4;
#pragma unroll
        for (int bj = 0; bj < 2; ++bj)
#pragma unroll
          for (int n = 0; n < 2; ++n) { const f32x4 a = acc[ai][bj][m][n]; u32x2 w; w[0] = cvtpk(a[0], a[1]); w[1] = cvtpk(a[2], a[3]); *(u32x2*)(rowp + bj * 128 + n * 16) = w; }
      }
  }
};
struct EpiRes {
  const float* base; long base_row0; float* X; const float* gate;
  __device__ __forceinline__ void operator()(f32x4 (&acc)[2][2][4][2], int brow, int bcol, int wr, int wc, int fr, int fq, char*) const {
    f32x4 g[2][2];
#pragma unroll
    for (int bj = 0; bj < 2; ++bj)
#pragma unroll
      for (int n = 0; n < 2; ++n) g[bj][n] = *(const f32x4*)(gate + bcol + bj * 128 + wc * 32 + n * 16 + fq * 4);
#pragma unroll
    for (int ai = 0; ai < 2; ++ai)
#pragma unroll
      for (int m = 0; m < 4; ++m) {
        if (m == 0 || m == 2) __builtin_amdgcn_sched_barrier(0);
        const long row = brow + ai * 128 + wr * 64 + m * 16 + fr; const int col0 = bcol + wc * 32 + fq * 4;
        const float* bp = base + (size_t)(row - base_row0) * DM + col0; float* xp = X + (size_t)row * DM + col0;
#pragma unroll
        for (int bj = 0; bj < 2; ++bj)
#pragma unroll
          for (int n = 0; n < 2; ++n) { const f32x4 bv = *(const f32x4*)(bp + bj * 128 + n * 16); *(f32x4*)(xp + bj * 128 + n * 16) = bv + g[bj][n] * acc[ai][bj][m][n]; }
      }
  }
};
struct EpiOut {
  const float* base; long base_row0; float* X; const float* gate; const float* n2g; const float* scl; bf16_t* H2; float* ssq;
  __device__ __forceinline__ void operator()(f32x4 (&acc)[2][2][4][2], int brow, int bcol, int wr, int wc, int fr, int fq, char*) const {
    f32x4 g[2][2], gm[2][2];
#pragma unroll
    for (int bj = 0; bj < 2; ++bj)
#pragma unroll
      for (int n = 0; n < 2; ++n) { const int col = bcol + bj * 128 + wc * 32 + n * 16 + fq * 4; g[bj][n] = *(const f32x4*)(gate + col); gm[bj][n] = *(const f32x4*)(n2g + col) * (*(const f32x4*)(scl + col) + 1.f); }
#pragma unroll
    for (int ai = 0; ai < 2; ++ai)
#pragma unroll
      for (int m = 0; m < 4; ++m) {
        const long row = brow + ai * 128 + wr * 64 + m * 16 + fr; const int col0 = bcol + wc * 32 + fq * 4;
        const float* bp = base + (size_t)(row - base_row0) * DM + col0; float* xp = X + (size_t)row * DM + col0; bf16_t* hp = H2 + (size_t)row * DM + col0;
        float ss = 0.f;
#pragma unroll
        for (int bj = 0; bj < 2; ++bj)
#pragma unroll
          for (int n = 0; n < 2; ++n) {
            const f32x4 xn = *(const f32x4*)(bp + bj * 128 + n * 16) + g[bj][n] * acc[ai][bj][m][n];
            *(f32x4*)(xp + bj * 128 + n * 16) = xn;
            ss += xn[0] * xn[0] + xn[1] * xn[1] + xn[2] * xn[2] + xn[3] * xn[3];
            const f32x4 hv = xn * gm[bj][n];
            u32x2 w; w[0] = cvtpk(hv[0], hv[1]); w[1] = cvtpk(hv[2], hv[3]);
            *(u32x2*)(hp + bj * 128 + n * 16) = w;
          }
        ss += swz_xor<16>(ss);
        { auto rr = __builtin_amdgcn_permlane32_swap(__float_as_uint(ss), __float_as_uint(ss), false, false); ss = __uint_as_float(rr[0]) + __uint_as_float(rr[1]); }
        if (fq == 0) (void)__hip_atomic_fetch_add(ssq + row, ss, __ATOMIC_RELAXED, __HIP_MEMORY_SCOPE_AGENT);
      }
  }
};
struct EpiUp {
  const float* cw; const float* cb; bf16_t* U; float* HA; float* HB; int pm, pn; const float* ssq; const float* sWr;
  __device__ __forceinline__ void operator()(f32x4 (&acc)[2][2][4][2], int brow, int bcol, int wr, int wc, int fr, int fq, char* lds) const {
    constexpr int AST = 272;
    { float rs[2][4];
#pragma unroll
      for (int ai = 0; ai < 2; ++ai)
#pragma unroll
        for (int m = 0; m < 4; ++m) rs[ai][m] = rsqrtf(ssq[brow + ai * 128 + wr * 64 + m * 16 + fr] * (1.f / DM) + EPS);
#pragma unroll
      for (int bj = 0; bj < 2; ++bj)
#pragma unroll
        for (int n = 0; n < 2; ++n) { const f32x4 sw = *(const f32x4*)(sWr + bcol + bj * 128 + wc * 32 + n * 16 + fq * 4);
#pragma unroll
          for (int ai = 0; ai < 2; ++ai)
#pragma unroll
            for (int m = 0; m < 4; ++m) acc[ai][bj][m][n] = acc[ai][bj][m][n] * rs[ai][m] + sw; } }
#pragma unroll
    for (int ai = 0; ai < 2; ++ai)
#pragma unroll
      for (int m = 0; m < 4; ++m)
#pragma unroll
        for (int n = 0; n < 2; ++n) { const f32x4 a = acc[ai][0][m][n]; u32x2 w; w[0] = cvtpk(a[0], a[1]); w[1] = cvtpk(a[2], a[3]);
          *(u32x2*)(lds + (ai * 128 + wr * 64 + m * 16 + fr) * AST + (wc * 32 + n * 16 + fq * 4) * 2) = w; }
    __syncthreads();
    f32x4 w0[2], w1[2], w2[2], bb[2];
#pragma unroll
    for (int n = 0; n < 2; ++n) { const int f = pn * 128 + wc * 32 + n * 16 + fq * 4;
      w0[n] = *(const f32x4*)(cw + f); w1[n] = *(const f32x4*)(cw + DFF + f); w2[n] = *(const f32x4*)(cw + 2 * DFF + f); bb[n] = *(const f32x4*)(cb + f); }
#pragma unroll
    for (int ai = 0; ai < 2; ++ai)
#pragma unroll
      for (int m = 0; m < 4; ++m) {
        const int rl = ai * 128 + wr * 64 + m * 16 + fr;
#pragma unroll
        for (int n = 0; n < 2; ++n) {
          const int c = wc * 32 + n * 16 + fq * 4;
          f32x4 up = {0.f, 0.f, 0.f, 0.f}, dn = {0.f, 0.f, 0.f, 0.f};
          if (rl > 0) { const u32x2 r = *(const u32x2*)(lds + (rl - 1) * AST + c * 2); up[0] = __uint_as_float(r[0] << 16); up[1] = __uint_as_float(r[0] & 0xffff0000u); up[2] = __uint_as_float(r[1] << 16); up[3] = __uint_as_float(r[1] & 0xffff0000u); }
          if (rl < 255) { const u32x2 r = *(const u32x2*)(lds + (rl + 1) * AST + c * 2); dn[0] = __uint_as_float(r[0] << 16); dn[1] = __uint_as_float(r[0] & 0xffff0000u); dn[2] = __uint_as_float(r[1] << 16); dn[3] = __uint_as_float(r[1] & 0xffff0000u); }
          const f32x4 a = acc[ai][0][m][n], v = acc[ai][1][m][n];
          const f32x4 cv = up * w0[n] + a * w1[n] + dn * w2[n] + bb[n];
          float u[4];
#pragma unroll
          for (int j = 0; j < 4; ++j) u[j] = silu_f(cv[j]) * v[j];
          u32x2 w; w[0] = cvtpk(u[0], u[1]); w[1] = cvtpk(u[2], u[3]);
          const int f = pn * 128 + c;
          *(u32x2*)(U + (size_t)(brow + rl) * DFF + f) = w;
          if (rl == 0 || rl == 255) {
            const int e = rl == 0 ? 0 : 1;
            *(f32x4*)(HA + ((size_t)(pm * 2 + e)) * DFF + f) = a;
            float* hb = HB + (((size_t)(pm * 2 + e)) * DFF + f) * 2;
            *(f32x4*)(hb) = (f32x4){cv[0], v[0], cv[1], v[1]};
            *(f32x4*)(hb + 4) = (f32x4){cv[2], v[2], cv[3], v[3]};
          }
        }
      }
  }
};

namespace at {
constexpr int D = 128, NW = 8, QBLK = 32, KVBLK = 64;
constexpr float SCALE = 0.088388347648318440f;
constexpr float THR = 8.f;
constexpr int LDQ = ZLD, LDK = 128, LDO = DM;
constexpr size_t SHM_V = KVBLK * D * 2, SHM_K = KVBLK * D * 2;
#define KSWZ(row, colB) ((row) * 256 + ((colB) ^ (((row) & 7) << 4)))
#define SBAR() __builtin_amdgcn_sched_barrier(0)
__device__ __forceinline__ int crow(int r, int hi) { return (r & 3) + 8 * (r >> 2) + 4 * hi; }
__device__ __forceinline__ void partialSM(f32x16& p0, f32x16& p1, float& m_reg, float& mn, float& alpha) {
  constexpr float C = SCALE * 1.4426950408889634f;
  float pmax = p0[0]; for (int r = 1; r < 16; ++r) pmax = fmaxf(pmax, p0[r]); for (int r = 0; r < 16; ++r) pmax = fmaxf(pmax, p1[r]);
  { auto rr = __builtin_amdgcn_permlane32_swap(__float_as_uint(pmax), __float_as_uint(pmax), false, false);
    pmax = fmaxf(__uint_as_float(rr[0]), __uint_as_float(rr[1])); }
  if (__builtin_expect(__all(pmax - m_reg <= THR / SCALE), 1)) { mn = m_reg; alpha = 1.f; }
  else { mn = fmaxf(m_reg, pmax); alpha = __builtin_amdgcn_exp2f((m_reg - mn) * C); m_reg = mn; }
  float mnC = -mn * C;
  for (int r = 0; r < 16; ++r) p0[r] = fmaf(p0[r], C, mnC); for (int r = 0; r < 16; ++r) p1[r] = fmaf(p1[r], C, mnC);
  for (int r = 0; r < 16; ++r) p0[r] = __builtin_amdgcn_exp2f(p0[r]);
}
__device__ __forceinline__ void finishSM(f32x16& p0, f32x16& p1, float alpha, float& l_reg, bf16x8& pa0, bf16x8& pa1, bf16x8& pa2, bf16x8& pa3) {
  for (int r = 0; r < 16; ++r) p1[r] = __builtin_amdgcn_exp2f(p1[r]);
  float ps = 0; for (int r = 0; r < 16; ++r) ps += p0[r]; for (int r = 0; r < 16; ++r) ps += p1[r];
  { auto rr = __builtin_amdgcn_permlane32_swap(__float_as_uint(ps), __float_as_uint(ps), false, false);
    ps = __uint_as_float(rr[0]) + __uint_as_float(rr[1]); }
  l_reg = l_reg * alpha + ps;
#define PK4(P, BASE, OUT) do { unsigned a0 = cvtpk_asm(P[BASE + 0], P[BASE + 1]), a1 = cvtpk_asm(P[BASE + 2], P[BASE + 3]);   \
    unsigned b0 = cvtpk_asm(P[BASE + 4], P[BASE + 5]), b1 = cvtpk_asm(P[BASE + 6], P[BASE + 7]);                              \
    auto r0 = __builtin_amdgcn_permlane32_swap(a0, b0, false, false); auto r1 = __builtin_amdgcn_permlane32_swap(a1, b1, false, false); \
    u32x4 w = {r0[0], r1[0], r0[1], r1[1]}; OUT = *reinterpret_cast<bf16x8*>(&w); } while (0)
  PK4(p0, 0, pa0); PK4(p0, 8, pa1); PK4(p1, 0, pa2); PK4(p1, 8, pa3);
#undef PK4
}
__device__ __forceinline__ void qkt(f32x16& p0, f32x16& p1, const bf16_t* Ks, const bf16x8* qr, int r32, int hi) {
  p0 = f32x16{}; p1 = f32x16{};
  for (int d0 = 0; d0 < 8; ++d0) { int cb = (d0 * 16 + hi * 8) * 2;
    bf16x8 b0 = *reinterpret_cast<const bf16x8*>((const char*)Ks + KSWZ(r32, cb));
    bf16x8 b1 = *reinterpret_cast<const bf16x8*>((const char*)Ks + KSWZ(32 + r32, cb));
    p0 = __builtin_amdgcn_mfma_f32_32x32x16_bf16(b0, qr[d0], p0, 0, 0, 0);
    p1 = __builtin_amdgcn_mfma_f32_32x32x16_bf16(b1, qr[d0], p1, 0, 0, 0); }
}
__device__ __forceinline__ int v_st(int k, int c) { const int kk = (k & ~0xC) | ((k & 4) << 1) | ((k & 8) >> 1); return ((kk >> 3) * 4 + (c >> 5)) * 512 + ((kk & 7) * 32 + (c & 31)) * 2; }
__device__ __forceinline__ int v_rd_base(int lane) { return ((lane & 3) << 3) | (((lane >> 2) & 3) << 6) | (((lane >> 4) & 1) << 5) | (((lane >> 5) & 1) << 8); }
constexpr int v_rd_off(int d0, int ks, int half) { return d0 * 512 + ks * 4096 + half * 2048; }
template <int OFF> __device__ __forceinline__ s16x4 tr_read(int vb) {
  s16x4 r; asm volatile("ds_read_b64_tr_b16 %0, %1 offset:%2" : "=&v"(r) : "v"(vb), "i"(OFF) : "memory"); return r;
}
template <int D0> __device__ __forceinline__ void pv_one(f32x16& od, int vb, bf16x8 pa0, bf16x8 pa1, bf16x8 pa2, bf16x8 pa3) {
  const s16x4 l0 = tr_read<v_rd_off(D0, 0, 0)>(vb), h0 = tr_read<v_rd_off(D0, 0, 1)>(vb), l1 = tr_read<v_rd_off(D0, 1, 0)>(vb), h1 = tr_read<v_rd_off(D0, 1, 1)>(vb);
  const s16x4 l2 = tr_read<v_rd_off(D0, 2, 0)>(vb), h2 = tr_read<v_rd_off(D0, 2, 1)>(vb), l3 = tr_read<v_rd_off(D0, 3, 0)>(vb), h3 = tr_read<v_rd_off(D0, 3, 1)>(vb);
  asm volatile("s_waitcnt lgkmcnt(0)" ::: "memory"); SBAR();
#define PK(L, H) (bf16x8){L[0], L[1], L[2], L[3], H[0], H[1], H[2], H[3]}
  od = __builtin_amdgcn_mfma_f32_32x32x16_bf16(pa0, PK(l0, h0), od, 0, 0, 0);
  od = __builtin_amdgcn_mfma_f32_32x32x16_bf16(pa1, PK(l1, h1), od, 0, 0, 0);
  od = __builtin_amdgcn_mfma_f32_32x32x16_bf16(pa2, PK(l2, h2), od, 0, 0, 0);
  od = __builtin_amdgcn_mfma_f32_32x32x16_bf16(pa3, PK(l3, h3), od, 0, 0, 0);
#undef PK
}
__device__ __forceinline__ void pv_d0(f32x16* o, int vb, bf16x8 pa0, bf16x8 pa1, bf16x8 pa2, bf16x8 pa3) {
  pv_one<0>(o[0], vb, pa0, pa1, pa2, pa3); pv_one<1>(o[1], vb, pa0, pa1, pa2, pa3); pv_one<2>(o[2], vb, pa0, pa1, pa2, pa3); pv_one<3>(o[3], vb, pa0, pa1, pa2, pa3);
}
__device__ __forceinline__ void attn_dense_body(const bf16_t* __restrict__ Qb, const bf16_t* __restrict__ Kh, const bf16_t* __restrict__ Vh,
                                                bf16_t* __restrict__ Ob, int seq, char* lds, int wv) {
  const int tid = otid(wv), wid = wv, lane = tid & 63, r32 = lane & 31, hi = lane >> 5;
  bf16_t* V_lds = (bf16_t*)lds; bf16_t* K_lds = (bf16_t*)(lds + 2 * SHM_V);
  float* ws = (float*)(lds + 2 * SHM_V + 2 * SHM_K) + wid * 64; float* li_l = ws; float* al_l = ws + 32;
  float m_reg = -1e30f, l_reg = 0; f32x16 o[4] = {}; bf16x8 qr[8];
  const bf16_t* Qw = Qb + (long)(wid * QBLK + r32) * LDQ + hi * 8;
#pragma unroll
  for (int d0 = 0; d0 < 8; ++d0) qr[d0] = *reinterpret_cast<const bf16x8*>(Qw + d0 * 16);
  const int sr = tid >> 4, sc = (tid & 15) * 8, vst0 = v_st(sr, sc), vst1 = v_st(32 + sr, sc);
  const int vb0 = (int)(uintptr_t)V_lds + v_rd_base(lane);
  struct { bf16x8 vs0, vs1, ks0, ks1; } sr_[2];
#define SLOAD(i, k0) do { sr_[i].vs0 = *reinterpret_cast<const bf16x8*>(&Vh[(long)((k0) + sr) * LDK + sc]); sr_[i].vs1 = *reinterpret_cast<const bf16x8*>(&Vh[(long)((k0) + 32 + sr) * LDK + sc]); \
    sr_[i].ks0 = *reinterpret_cast<const bf16x8*>(&Kh[(long)((k0) + sr) * LDK + sc]); sr_[i].ks1 = *reinterpret_cast<const bf16x8*>(&Kh[(long)((k0) + 32 + sr) * LDK + sc]); } while (0)
#define SWRITE(b, i) do { *(bf16x8*)((char*)V_lds + (b) * SHM_V + vst0) = sr_[i].vs0;          \
    *(bf16x8*)((char*)V_lds + (b) * SHM_V + vst1) = sr_[i].vs1; int kc = sc * 2;               \
    *(bf16x8*)((char*)K_lds + (b) * SHM_K + KSWZ(sr, kc)) = sr_[i].ks0;                       \
    *(bf16x8*)((char*)K_lds + (b) * SHM_K + KSWZ(32 + sr, kc)) = sr_[i].ks1; } while (0)
#define SWAIT() asm volatile("s_waitcnt vmcnt(4)" ::: "memory")
#define RESC(a) do { if (__any((a) < 1.f)) { if (hi == 0) al_l[r32] = (a); asm volatile("s_waitcnt lgkmcnt(0)" ::: "memory"); \
    for (int d = 0; d < 4; ++d) for (int r = 0; r < 16; ++r) o[d][r] *= al_l[crow(r, hi)]; } } while (0)
  f32x16 pA0, pA1, pB0, pB1; float mnA, mnB, alA, alB; bf16x8 pa0, pa1, pa2, pa3; const int NT = seq / KVBLK;
  constexpr int SE = 0, SO = 1;
  SLOAD(SE, 0); asm volatile("s_waitcnt vmcnt(0)" ::: "memory"); SWRITE(0, SE); __syncthreads();
  qkt(pA0, pA1, K_lds, qr, r32, hi); partialSM(pA0, pA1, m_reg, mnA, alA);
  SLOAD(SO, KVBLK); if (2 < NT) SLOAD(SE, 2 * KVBLK);
  SWAIT(); SWRITE(1, SO); __syncthreads();
  for (int j = 1; j + 1 < NT; j += 2) {
    SBAR(); qkt(pB0, pB1, (bf16_t*)((char*)K_lds + SHM_K), qr, r32, hi);
    finishSM(pA0, pA1, alA, l_reg, pa0, pa1, pa2, pa3); SBAR();
    SLOAD(SO, (j + 2) * KVBLK); SBAR();
    pv_d0(o, vb0, pa0, pa1, pa2, pa3); partialSM(pB0, pB1, m_reg, mnB, alB);
    __syncthreads(); SWAIT(); SWRITE(0, SE);
    RESC(alB); __syncthreads();
    SBAR(); qkt(pA0, pA1, K_lds, qr, r32, hi);
    finishSM(pB0, pB1, alB, l_reg, pa0, pa1, pa2, pa3); SBAR();
    if (j + 3 < NT) SLOAD(SE, (j + 3) * KVBLK); SBAR();
    pv_d0(o, vb0 + (int)SHM_V, pa0, pa1, pa2, pa3); partialSM(pA0, pA1, m_reg, mnA, alA);
    __syncthreads(); SWAIT(); SWRITE(1, SO);
    RESC(alA); __syncthreads();
  }
  SBAR(); qkt(pB0, pB1, (bf16_t*)((char*)K_lds + SHM_K), qr, r32, hi);
  finishSM(pA0, pA1, alA, l_reg, pa0, pa1, pa2, pa3); SBAR();
  pv_d0(o, vb0, pa0, pa1, pa2, pa3); partialSM(pB0, pB1, m_reg, mnB, alB);
  __syncthreads(); RESC(alB);
  finishSM(pB0, pB1, alB, l_reg, pa0, pa1, pa2, pa3); SBAR();
  pv_d0(o, vb0 + (int)SHM_V, pa0, pa1, pa2, pa3);
  if (hi == 0) li_l[r32] = l_reg; asm volatile("s_waitcnt lgkmcnt(0)" ::: "memory");
  float rli[16];
#pragma unroll
  for (int r = 0; r < 16; ++r) rli[r] = __builtin_amdgcn_rcpf(li_l[crow(r, hi)]);
  bf16_t* Ow = Ob + (long)(wid * QBLK) * LDO;
#pragma unroll
  for (int r = 0; r < 16; ++r) { int orow = crow(r, hi);
#pragma unroll
    for (int d0 = 0; d0 < 4; ++d0) Ow[(long)orow * LDO + d0 * 32 + r32] = f2bf(o[d0][r] * rli[r]); }
#undef SLOAD
#undef SWRITE
#undef SWAIT
#undef RESC
}
}

__device__ __forceinline__ void prep_phase(KP p, int wv, int l, char* lds) {
  p = relaunder(p);
  const int tid = otid(wv), wid = tid >> 6, lane = tid & 63;
  const float qg1 = p->q_norm_g[l * 128 + lane], qg2 = p->q_norm_g[l * 128 + 64 + lane];
  const float kg1 = p->k_norm_g[l * 128 + lane], kg2 = p->k_norm_g[l * 128 + 64 + lane];
  const float invf = powf(10000.f, -(float)(lane & 31) / 32.f);
  for (int row = blockIdx.x * 8 + wid; row < NROWS; row += gridDim.x * 8) {
    const int rb = row % RPB; const bool lat = rb >= CTX; const int t = rb - CTX;
    float cs = 1.f, sn = 0.f;
    if (lat) { const float pos = (lane < 32) ? (float)(t >> 6) : (float)(t & 63); const float ang = pos * invf; sincosf(ang, &sn, &cs); }
    bf16_t* zr = p->Z + (size_t)row * ZLD;
    bf16_t r1[18], r2[18];
#pragma unroll
    for (int hs = 0; hs < 18; ++hs) {
      const int col0 = hs < 8 ? C_AQ + hs * 128 : hs < 10 ? C_AK + (hs - 8) * 128 : hs < 14 ? C_RQ + (hs - 10) * 128 : C_RK + (hs - 14) * 128;
      r1[hs] = zr[col0 + lane]; r2[hs] = zr[col0 + 64 + lane];
    }
    const u32x2 vcopy = *(const u32x2*)(zr + C_AV + (lane >> 5) * 128 + (lane & 31) * 4);
#pragma unroll
    for (int hs = 0; hs < 18; ++hs) {
      const int col0 = hs < 8 ? C_AQ + hs * 128 : hs < 10 ? C_AK + (hs - 8) * 128 : hs < 14 ? C_RQ + (hs - 10) * 128 : C_RK + (hs - 14) * 128;
      float x1 = bf2f(r1[hs]), x2 = bf2f(r2[hs]);
      if (hs < 10) {
        const float ss = wave_sum(x1 * x1 + x2 * x2);
        const float r = rsqrtf(ss * (1.f / 128.f) + EPS);
        x1 = x1 * r * (hs < 8 ? qg1 : kg1); x2 = x2 * r * (hs < 8 ? qg2 : kg2);
      }
      if (hs >= 14) { x1 *= 0.088388347648318440f; x2 *= 0.088388347648318440f; }
      const float o1 = x1 * cs - x2 * sn, o2 = x1 * sn + x2 * cs;
      if (hs == 8 || hs == 9) { bf16_t* kc = p->Kc + ((size_t)((row / RPB) * 2 + (hs - 8)) * RPB + rb) * 128; kc[lane] = f2bf(o1); kc[64 + lane] = f2bf(o2); }
      else { zr[col0 + lane] = f2bf(o1); zr[col0 + 64 + lane] = f2bf(o2); }
    }
    { const int kvh = lane >> 5, d4 = (lane & 31) * 4;
      *(u32x2*)(p->Vc + ((size_t)((row / RPB) * 2 + kvh) * RPB + rb) * 128 + d4) = vcopy; }
  }
  {
    const int dir = tid >> 8, col = tid & 255;
    float up[16];
#pragma unroll
    for (int r = 0; r < 16; ++r) up[r] = p->gla_gate_up[((size_t)(l * 2 + dir) * 16 + r) * 256 + col];
    const float bias = p->gla_gate_b[(l * 2 + dir) * 256 + col];
    for (int ch = (int)gridDim.x - 1 - (int)blockIdx.x; ch < NROWS / 64; ch += gridDim.x) {
      float bacc = 0.f;
#pragma unroll 1
      for (int s0 = 0; s0 < 64; s0 += 8) {
        bf16x8 g0[8], g1[8]; bf16_t qv[8], kv[8];
#pragma unroll
        for (int j = 0; j < 8; ++j) {
          const int row = ch * 64 + (dir ? 63 - (s0 + j) : (s0 + j));
          const bf16_t* zr = p->Z + (size_t)row * ZLD;
          g0[j] = *(const bf16x8*)(zr + C_GA + dir * 16); g1[j] = *(const bf16x8*)(zr + C_GA + dir * 16 + 8);
          qv[j] = zr[C_GQ + col]; kv[j] = zr[C_GK + col];
        }
#pragma unroll
        for (int j = 0; j < 8; ++j) {
          const int row = ch * 64 + (dir ? 63 - (s0 + j) : (s0 + j));
          float logit = bias;
#pragma unroll
          for (int r = 0; r < 8; ++r) logit += bf2f((bf16_t)g0[j][r]) * up[r] + bf2f((bf16_t)g1[j][r]) * up[8 + r];
          const float ls = fminf(logit, 0.f) - 0.6931471805599453f * __builtin_amdgcn_logf(1.f + fexp(-fabsf(logit)));
          bacc += ls * (1.f / 16.f);
          const size_t o = ((size_t)dir * NROWS + row) * 256 + col;
          p->GQt[o] = f2bf(bf2f(qv[j]) * 0.125f * fexp(bacc));
          p->GKt[o] = f2bf(bf2f(kv[j]) * fexp(-bacc));
        }
      }
      p->Eend[((size_t)dir * (NROWS / 64) + ch) * 256 + col] = fexp(bacc);
    }
  }
  for (int u = blockIdx.x; u < 2 * DFF / 32; u += gridDim.x) gemv9_unit<1>(p, wv, u, l, lds);
  if (l == 0) for (int u = (int)gridDim.x - 1 - (int)blockIdx.x; u < ZLD / 32; u += gridDim.x) gemv9_unit<2>(p, wv, u, 1, lds);
}

__device__ __forceinline__ int scan_row(int b, int s, int dir) { return b * RPB + (dir == 0 ? s : (s < CTX ? CTX - 1 - s : RPB + CTX - 1 - s)); }

#define MFMA16(a, b, c) __builtin_amdgcn_mfma_f32_16x16x32_bf16(a, b, c, 0, 0, 0)
__device__ __forceinline__ bf16x8 pack8(u32x2 lo, u32x2 hi) { u32x4 w = {lo[0], lo[1], hi[0], hi[1]}; return *reinterpret_cast<bf16x8*>(&w); }

__device__ __forceinline__ void ret_scan_unit(KP p, int wv, int l, int u, bool last, char* lds) {
  p = relaunder(p);
  constexpr int ST = 272, IMG = 128 * ST;
  char* Qs = lds; char* Ks = lds + IMG; char* KTs = lds + 2 * IMG; char* VTs = lds + 3 * IMG;
  const int tid = otid(wv), wid = wv, lane = tid & 63, fr = lane & 15, fq = lane >> 4;
  const int b = u >> 3, h = (u >> 1) & 3, dir = u & 1;
  const float lg2 = p->ret_log_decay[l * 8 + dir * 4 + h] * 1.4426950408889634f;
  const float cdec = __builtin_amdgcn_exp2f(lg2 * 128.f);
  const int sr = tid >> 2, sc = (tid & 3) * 32;
  const float vsc = __builtin_amdgcn_exp2f(lg2 * (float)(127 - sr));
  bf16x8 rq[4], rk[4], rv[4];
#define RLOAD(c) do { const bf16_t* base_ = p->Z + (size_t)scan_row(b, (c) * 128 + sr, dir) * ZLD + h * 128 + sc; \
    _Pragma("unroll") for (int k = 0; k < 4; ++k) { rq[k] = *(const bf16x8*)(base_ + C_RQ + k * 8); rk[k] = *(const bf16x8*)(base_ + C_RK + k * 8); rv[k] = *(const bf16x8*)(base_ + C_RV + k * 8); } } while (0)
  f32x4 S[8];
#pragma unroll
  for (int i = 0; i < 8; ++i) S[i] = (f32x4){0.f, 0.f, 0.f, 0.f};
  RLOAD(0);
#pragma unroll 1
  for (int c = 0; c < 18; ++c) {
#pragma unroll
    for (int k = 0; k < 4; ++k) {
      *(bf16x8*)(Qs + sr * ST + (sc + k * 8) * 2) = rq[k];
      *(bf16x8*)(Ks + sr * ST + (sc + k * 8) * 2) = rk[k];
#pragma unroll
      for (int e = 0; e < 8; ++e) {
        const int d = sc + k * 8 + e;
        *(bf16_t*)(KTs + d * ST + (sr ^ ((tid & 3) << 4)) * 2) = (bf16_t)rk[k][e];
        *(bf16_t*)(VTs + d * ST + (sr ^ ((tid & 3) << 4)) * 2) = f2bf(bf2f((bf16_t)rv[k][e]) * vsc);
      }
    }
    if (c + 1 < 18) RLOAD(c + 1);
    __syncthreads();
    bf16x8 vf[4];
#pragma unroll
    for (int ks = 0; ks < 4; ++ks) vf[ks] = *(const bf16x8*)(VTs + (16 * wid + fr) * ST + ((ks * 32 + fq * 8) ^ (((wid >> 1) & 3) << 4)) * 2);
    const bool need_out = !(last && c < 2);
    if (need_out) {
      bf16x8 qf[4];
#pragma unroll
      for (int ks = 0; ks < 4; ++ks) qf[ks] = *(const bf16x8*)(Qs + (16 * wid + fr) * ST + (ks * 32 + fq * 8) * 2);
      u32x2 pt[8];
#pragma unroll
      for (int jt = 0; jt < 8; ++jt) {
        pt[jt] = (u32x2){0u, 0u};
        if (jt <= wid) {
          f32x4 a = {0.f, 0.f, 0.f, 0.f};
#pragma unroll
          for (int ks = 0; ks < 4; ++ks) { const bf16x8 kf = *(const bf16x8*)(Ks + (16 * jt + fr) * ST + (ks * 32 + fq * 8) * 2); a = MFMA16(kf, qf[ks], a); }
          if (jt == wid) {
#pragma unroll
            for (int jj = 0; jj < 4; ++jj) if (4 * fq + jj > fr) a[jj] = 0.f;
          }
          pt[jt][0] = cvtpk(a[0], a[1]); pt[jt][1] = cvtpk(a[2], a[3]);
        }
      }
      __syncthreads();
#pragma unroll
      for (int jt = 0; jt < 8; ++jt)
        if (jt <= wid || (jt == wid + 1 && !(wid & 1))) *(u32x2*)(Ks + (16 * wid + fr) * ST + (16 * jt + 4 * fq) * 2) = pt[jt];
      __syncthreads();
      bf16x8 sop[4];
#pragma unroll
      for (int s = 0; s < 4; ++s) { u32x4 w = {cvtpk(S[2 * s][0], S[2 * s][1]), cvtpk(S[2 * s][2], S[2 * s][3]), cvtpk(S[2 * s + 1][0], S[2 * s + 1][1]), cvtpk(S[2 * s + 1][2], S[2 * s + 1][3])}; sop[s] = *reinterpret_cast<bf16x8*>(&w); }
#pragma unroll
      for (int it = 0; it < 8; ++it) {
        f32x4 aO = {0.f, 0.f, 0.f, 0.f}, aT = {0.f, 0.f, 0.f, 0.f};
#pragma unroll
        for (int ks = 0; ks < 4; ++ks) if (ks <= (it >> 1)) { const bf16x8 pf = *(const bf16x8*)(Ks + (16 * it + fr) * ST + (ks * 32 + fq * 8) * 2); aO = MFMA16(vf[ks], pf, aO); }
#pragma unroll
        for (int s = 0; s < 4; ++s) {
          const u32x2 lo = *(const u32x2*)(Qs + (16 * it + fr) * ST + (32 * s + 4 * fq) * 2), hi = *(const u32x2*)(Qs + (16 * it + fr) * ST + (32 * s + 16 + 4 * fq) * 2);
          aT = MFMA16(sop[s], pack8(lo, hi), aT);
        }
        const int i = 16 * it + fr;
        const float sP = __builtin_amdgcn_exp2f(lg2 * (float)(i - 127)), sS = __builtin_amdgcn_exp2f(lg2 * (float)(i + 1));
        { const f32x4 o = aO * sP + aT * sS; u32x2 w; w[0] = cvtpk(o[0], o[1]); w[1] = cvtpk(o[2], o[3]);
          *(u32x2*)(p->RO + ((size_t)dir * NROWS + scan_row(b, c * 128 + i, dir)) * 512 + h * 128 + 16 * wid + 4 * fq) = w; }
      }
    }
#pragma unroll
    for (int td = 0; td < 8; ++td) {
      f32x4 a = S[td] * cdec;
#pragma unroll
      for (int ks = 0; ks < 4; ++ks) { const bf16x8 ktf = *(const bf16x8*)(KTs + (16 * td + fr) * ST + ((ks * 32 + fq * 8) ^ (((td >> 1) & 3) << 4)) * 2); a = MFMA16(ktf, vf[ks], a); }
      S[td] = a;
    }
    __syncthreads();
  }
#undef RLOAD
}

__device__ __forceinline__ void gla_scan_unit(KP p, int wv, int l, int u, bool last, char* lds) {
  p = relaunder(p);
  constexpr int ST = 144;
  char* Qs = lds; char* Ks = lds + 64 * ST; char* KTs = lds + 128 * ST; char* VTs = lds + 192 * ST;
  const int tid = otid(wv), wid = wv, lane = tid & 63, fr = lane & 15, fq = lane >> 4;
  const int b = u >> 3, h = (u >> 1) & 3, dir = u & 1;
  const int sr = tid >> 3, sc8 = (tid & 7) * 8, sc16 = (tid & 7) * 16;
  bf16x8 rq, rk, rv[2];
#define GLOAD(c) do { const int row_ = scan_row(b, (c) * 64 + sr, dir); const size_t o_ = ((size_t)dir * NROWS + row_) * 256 + h * 64 + sc8; \
    rq = *(const bf16x8*)(p->GQt + o_); rk = *(const bf16x8*)(p->GKt + o_); const bf16_t* vb_ = p->Z + (size_t)row_ * ZLD + C_GV + h * 128 + sc16; \
    rv[0] = *(const bf16x8*)(vb_); rv[1] = *(const bf16x8*)(vb_ + 8); } while (0)
  f32x4 S[4];
#pragma unroll
  for (int i = 0; i < 4; ++i) S[i] = (f32x4){0.f, 0.f, 0.f, 0.f};
  GLOAD(0);
#pragma unroll 1
  for (int c = 0; c < 36; ++c) {
    *(bf16x8*)(Qs + sr * ST + sc8 * 2) = rq;
    *(bf16x8*)(Ks + sr * ST + sc8 * 2) = rk;
#pragma unroll
    for (int e = 0; e < 8; ++e) *(bf16_t*)(KTs + (sc8 + e) * ST + sr * 2) = (bf16_t)rk[e];
#pragma unroll
    for (int k = 0; k < 2; ++k)
#pragma unroll
      for (int e = 0; e < 8; ++e) *(bf16_t*)(VTs + (sc16 + k * 8 + e) * ST + sr * 2) = (bf16_t)rv[k][e];
    const int chid = scan_row(b, c * 64 + (dir ? 63 : 0), dir) >> 6;
    f32x4 ee[4];
#pragma unroll
    for (int td = 0; td < 4; ++td) ee[td] = *(const f32x4*)(p->Eend + ((size_t)dir * (NROWS / 64) + chid) * 256 + h * 64 + 16 * td + 4 * fq);
    if (c + 1 < 36) GLOAD(c + 1);
    __syncthreads();
    bf16x8 vf[2];
#pragma unroll
    for (int ks = 0; ks < 2; ++ks) vf[ks] = *(const bf16x8*)(VTs + (16 * wid + fr) * ST + (ks * 32 + fq * 8) * 2);
    const bool need_out = !(last && c < 4);
    if (need_out) {
      const int it = wid >> 1, jt0 = (wid & 1) * 2;
      bf16x8 qf[2];
#pragma unroll
      for (int ks = 0; ks < 2; ++ks) qf[ks] = *(const bf16x8*)(Qs + (16 * it + fr) * ST + (ks * 32 + fq * 8) * 2);
      u32x2 pt[2];
#pragma unroll
      for (int t = 0; t < 2; ++t) {
        const int jt = jt0 + t;
        pt[t] = (u32x2){0u, 0u};
        if (jt <= it) {
          f32x4 a = {0.f, 0.f, 0.f, 0.f};
#pragma unroll
          for (int ks = 0; ks < 2; ++ks) { const bf16x8 kf = *(const bf16x8*)(Ks + (16 * jt + fr) * ST + (ks * 32 + fq * 8) * 2); a = MFMA16(kf, qf[ks], a); }
          if (jt == it) {
#pragma unroll
            for (int jj = 0; jj < 4; ++jj) if (4 * fq + jj > fr) a[jj] = 0.f;
          }
          pt[t][0] = cvtpk(a[0], a[1]); pt[t][1] = cvtpk(a[2], a[3]);
        }
      }
      __syncthreads();
#pragma unroll
      for (int t = 0; t < 2; ++t) *(u32x2*)(Ks + (16 * it + fr) * ST + (16 * (jt0 + t) + 4 * fq) * 2) = pt[t];
      __syncthreads();
      bf16x8 sop[2];
#pragma unroll
      for (int s = 0; s < 2; ++s) { u32x4 w = {cvtpk(S[2 * s][0], S[2 * s][1]), cvtpk(S[2 * s][2], S[2 * s][3]), cvtpk(S[2 * s + 1][0], S[2 * s + 1][1]), cvtpk(S[2 * s + 1][2], S[2 * s + 1][3])}; sop[s] = *reinterpret_cast<bf16x8*>(&w); }
#pragma unroll
      for (int i2 = 0; i2 < 4; ++i2) {
        f32x4 a = {0.f, 0.f, 0.f, 0.f};
#pragma unroll
        for (int ks = 0; ks < 2; ++ks) if (ks <= (i2 >> 1)) { const bf16x8 pf = *(const bf16x8*)(Ks + (16 * i2 + fr) * ST + (ks * 32 + fq * 8) * 2); a = MFMA16(vf[ks], pf, a); }
#pragma unroll
        for (int s = 0; s < 2; ++s) {
          const u32x2 lo = *(const u32x2*)(Qs + (16 * i2 + fr) * ST + (32 * s + 4 * fq) * 2), hi = *(const u32x2*)(Qs + (16 * i2 + fr) * ST + (32 * s + 16 + 4 * fq) * 2);
          a = MFMA16(sop[s], pack8(lo, hi), a);
        }
        { u32x2 w; w[0] = cvtpk(a[0], a[1]); w[1] = cvtpk(a[2], a[3]);
          *(u32x2*)(p->GO + ((size_t)dir * NROWS + scan_row(b, c * 64 + 16 * i2 + fr, dir)) * 512 + h * 128 + 16 * wid + 4 * fq) = w; }
      }
    }
#pragma unroll
    for (int td = 0; td < 4; ++td) {
      f32x4 a = S[td];
#pragma unroll
      for (int ks = 0; ks < 2; ++ks) { const bf16x8 ktf = *(const bf16x8*)(KTs + (16 * td + fr) * ST + (ks * 32 + fq * 8) * 2); a = MFMA16(ktf, vf[ks], a); }
      S[td] = a * ee[td];
    }
    __syncthreads();
  }
#undef GLOAD
}

__device__ __forceinline__ void attn_unit(KP p, int wv, int a, char* lds) {
  p = relaunder(p);
  int b, h, kvh, qrow0, seq;
  if (a < 512) { const int x = a & 7, j = (a >> 3) & 31, rnd = a >> 8; b = rnd * 4 + (x >> 1); kvh = x & 1; h = kvh * 4 + (j >> 3); qrow0 = b * RPB + CTX + (j & 7) * 256; seq = RPB; }
  else { const int c = a - 512; b = c >> 3; h = c & 7; kvh = h >> 2; qrow0 = b * RPB; seq = CTX; }
  const bf16_t* Q = p->Z + (size_t)qrow0 * ZLD + C_AQ + h * 128;
  const bf16_t* Kp = p->Kc + (size_t)(b * 2 + kvh) * RPB * 128;
  const bf16_t* Vp = p->Vc + (size_t)(b * 2 + kvh) * RPB * 128;
  at::attn_dense_body(Q, Kp, Vp, p->H + (size_t)qrow0 * DM + h * 128, seq, lds, wv);
  __syncthreads();
}
__device__ __forceinline__ void mix1_phase(KP p, int wv, int l, bool last, char* lds, volatile LAS unsigned* bc) {
  p = relaunder(p);
  const int i = blockIdx.x;
  {
  if (i < 64) ret_scan_unit(p, wv, l, i, last, lds); else if (i < 128) gla_scan_unit(p, wv, l, i - 64, last, lds);
  }
  for (int u = i + 128; u < 128; u += gridDim.x) { if (u < 64) ret_scan_unit(p, wv, l, u, last, lds); else gla_scan_unit(p, wv, l, u - 64, last, lds); }
  const int q = i & 7, nq = last ? 64 : 72;
  for (;;) {
    unsigned* head = p->ctl + WQ_WORD(l, q); asm volatile("" : "+s"(head));
    volatile LAS unsigned* bcl = bc; asm volatile("" : "+s"(bcl));
    __syncthreads();
    if (otid(wv) == 0) bcl[2] = xb_add(head, 1u);
    __syncthreads();
    const int k = __builtin_amdgcn_readfirstlane((int)bcl[2]);
    if (k >= nq) break;
    attn_unit(p, wv, q + 8 * k, lds);
  }
}

__device__ __forceinline__ void mix2_phase(KP p, int wv, int l, bool last) {
  p = relaunder(p);
  const int tid_ = otid(wv); const int wid = wv, lane = tid_ & 63;
  const float rg1 = p->ret_norm_g[l * 128 + lane], rg2 = p->ret_norm_g[l * 128 + 64 + lane];
  const float gg1 = p->gla_norm_g[l * 128 + lane], gg2 = p->gla_norm_g[l * 128 + 64 + lane];
  for (int row = blockIdx.x * 8 + wid; row < NROWS; row += gridDim.x * 8) {
    if (last && (row % RPB) < CTX) continue;
    float x1[8], x2[8], g1[8], g2[8];
#pragma unroll
    for (int slot = 0; slot < 8; ++slot) {
      const bool isg = slot >= 4; const int h = slot & 3;
      const bf16_t* O = isg ? p->GO : p->RO;
      const size_t o0 = (size_t)row * 512 + h * 128, o1 = ((size_t)NROWS + row) * 512 + h * 128;
      x1[slot] = bf2f(__builtin_nontemporal_load(O + o0 + lane)) + bf2f(__builtin_nontemporal_load(O + o1 + lane)); x2[slot] = bf2f(__builtin_nontemporal_load(O + o0 + 64 + lane)) + bf2f(__builtin_nontemporal_load(O + o1 + 64 + lane));
      const bf16_t* zg = p->Z + (size_t)row * ZLD + (isg ? C_GR : C_RG) + h * 128;
      g1[slot] = bf2f(zg[lane]); g2[slot] = bf2f(zg[64 + lane]);
    }
#pragma unroll
    for (int slot = 0; slot < 8; ++slot) {
      const bool isg = slot >= 4;
      const float ss = wave_sum(x1[slot] * x1[slot] + x2[slot] * x2[slot]);
      const float r = rsqrtf(ss * (1.f / 128.f) + EPS);
      bf16_t* hp = p->H + (size_t)row * DM + 1024 + slot * 128;
      hp[lane] = f2bf(x1[slot] * r * (isg ? gg1 : rg1) * silu_f(g1[slot]));
      hp[64 + lane] = f2bf(x2[slot] * r * (isg ? gg2 : rg2) * silu_f(g2[slot]));
    }
  }
}

__device__ __forceinline__ void fixup_phase(KP p, int wv, int l, bool last) {
  p = relaunder(p);
  const float* cw = p->conv_w + (size_t)l * 3 * DFF;
  const int total = 72 * 2 * DFF;
  const int tid_ = otid(wv);
  for (int i = blockIdx.x * NTHR + tid_; i < total; i += gridDim.x * NTHR) {
    const int f = i % DFF, pe = i / DFF, pm = pe >> 1, e = pe & 1, k = pm % 9;
    if (k == 0) continue;
    if (e == 0 && k == 1) continue;
    if (e == 1 && k == 8) continue;
    const float* hb = p->HB + (((size_t)(pm * 2 + e)) * DFF + f) * 2;
    const float part = hb[0], v = hb[1];
    float cvv; int row;
    if (e == 0) { const float an = p->HA[((size_t)((pm - 1) * 2 + 1)) * DFF + f]; cvv = part + an * cw[f]; row = pm * 256; }
    else { const float an = p->HA[((size_t)((pm + 1) * 2 + 0)) * DFF + f]; cvv = part + an * cw[2 * DFF + f]; row = pm * 256 + 255; }
    p->U[(size_t)row * DFF + f] = f2bf(silu_f(cvv) * v);
  }
}

__device__ __forceinline__ void final_phase(KP p, int wv) {
  p = relaunder(p);
  const int tid_ = otid(wv); const int wid = wv, lane = tid_ & 63;
  for (int r0 = (blockIdx.x * 8 + wid) * 2; r0 < NB * SEQ; r0 += gridDim.x * 16) {
    f32x4 v[2][8];
#pragma unroll
    for (int q = 0; q < 2; ++q) { const int rr = r0 + q, b = rr / SEQ, t = rr % SEQ; const float* xr = p->X + (size_t)(b * RPB + CTX + t) * DM;
#pragma unroll
      for (int i = 0; i < 8; ++i) v[q][i] = *(const f32x4*)(xr + i * 256 + lane * 4); }
#pragma unroll
    for (int q = 0; q < 2; ++q) {
      float ss = 0.f;
#pragma unroll
      for (int i = 0; i < 8; ++i) ss += v[q][i][0] * v[q][i][0] + v[q][i][1] * v[q][i][1] + v[q][i][2] * v[q][i][2] + v[q][i][3] * v[q][i][3];
      ss = wave_sum(ss);
      const float r = rsqrtf(ss * (1.f / DM) + EPS);
#pragma unroll
      for (int i = 0; i < 8; ++i) { const int col = i * 256 + lane * 4; const f32x4 gg = *(const f32x4*)(p->final_norm_g + col);
        __builtin_nontemporal_store(v[q][i] * r * gg, (f32x4*)(p->out + (size_t)(r0 + q) * DM + col)); }
    }
  }
}

#define GSYNC() xcd_barrier(xbar)
template <int l>
__device__ __forceinline__ void layer_body(KP p, int wv, char* shm, cg::grid_group& grid, const XcdBarrier& xbar, volatile LAS unsigned* bcw) {
  constexpr bool last = (l == 1);
  const int G = gridDim.x;

    if (l == 0) {
      for (int u = blockIdx.x; u < 768; u += G) gemv9_unit<0>(p, wv, u, 0, shm);
      conv_phase(p, wv, 0, shm, 0, CV_IN + CV_OUT, 0);
      if (p->out == nullptr) grid.sync();
      GSYNC();
      norm_phase(p, wv, 0, 0, true, false);
      GSYNC();
    }
    for (int i = blockIdx.x; i < 72 * 21; i += G) { int pm, pn, qm = -1, qn = -1; tile_map(i, 72, 21, pm, pn, 4); if (i + G < 72 * 21) tile_map(i + G, 72, 21, qm, qn, 4);
      const bool pre = i != (int)blockIdx.x; const int nr = qm < 0 ? -1 : qm * 256, nc = qn * 256;
      if (l == 0) { EpiBf16<false> epi{p->Z, ZLD, nullptr, nullptr}; gemm_tile(p->H, DM, p->Wt_in, DM, DM, pm * 256, pn * 256, shm, epi, wv, pre, nr, nc); }
      else { EpiBf16<true> epi{p->Z, ZLD, (const float*)(p->ctl + SSQ_WORD) + (size_t)2 * NROWS, p->sWin + (size_t)((pm % 9) == 0 ? 8 : pm / 9) * ZLD}; gemm_tile(p->H, DM, p->Wt_in, DM, DM, pm * 256, pn * 256, shm, epi, wv, pre, nr, nc); } }
    GSYNC();
    prep_phase(p, wv, l, shm);
    if (l == 1) conv_phase(p, wv, 1, shm, CV_IN + CV_OUT + CV_UP, CV_TOTAL, 0);
    GSYNC();
    {
      mix1_phase(p, wv, l, last, shm, bcw);
      GSYNC();
    }
    {
      mix2_phase(p, wv, l, last);
      GSYNC();
    }
    { const int nM = last ? 64 : 72;
      for (int i = blockIdx.x; i < nM * 8; i += G) { int pm, pn, qm = -1, qn = -1; tile_map(i, nM, 8, pm, pn); if (last) pm = (pm >> 3) * 9 + 1 + (pm & 7);
        if (i + G < nM * 8) { tile_map(i + G, nM, 8, qm, qn); if (last) qm = (qm >> 3) * 9 + 1 + (qm & 7); }
        const bool pre = i != (int)blockIdx.x; const int nr = qm < 0 ? -1 : qm * 256, nc = qn * 256;
        const int b = pm / 9; const bool isctx = (pm % 9) == 0;
        const int mr = l * 9 + (isctx ? 8 : b);
        EpiOut epi;
        if (l == 0) { epi.base = isctx ? p->ctx + (size_t)b * CTX * DM : p->x + (size_t)b * SEQ * DM; epi.base_row0 = isctx ? (long)b * RPB : (long)b * RPB + CTX; }
        else { epi.base = p->X; epi.base_row0 = 0; }
        epi.X = p->X; epi.gate = p->mod + (size_t)mr * NMOD + 2 * DM; epi.n2g = p->norm2_g + l * DM; epi.scl = p->mod + (size_t)mr * NMOD + 4 * DM;
        epi.H2 = (bf16_t*)p->RO; epi.ssq = (float*)(p->ctl + SSQ_WORD) + (size_t)l * NROWS;
        gemm_tile(p->H, DM, p->Wt_out, DM, DM, pm * 256, pn * 256, shm, epi, wv, pre, nr, nc); }
      if (l == 0) conv_phase(p, wv, 0, shm, CV_IN + CV_OUT, CV_TOTAL, (nM * 8) % G ? (nM * 8) % G : 0); }
    GSYNC();
    {
      const int nM = last ? 64 : 72;
      for (int i = blockIdx.x; i < nM * 44; i += G) { int pm, pn; tile_map(i, nM, 44, pm, pn); if (last) pm = (pm >> 3) * 9 + 1 + (pm & 7);
        const int mr = l * 9 + ((pm % 9) == 0 ? 8 : pm / 9);
        EpiUp epi{p->conv_w + (size_t)l * 3 * DFF, p->conv_b + (size_t)l * DFF, p->U, p->HA, p->HB, pm, pn, (const float*)(p->ctl + SSQ_WORD) + (size_t)l * NROWS, p->sW + (size_t)mr * (2 * DFF)};
        gemm_tile((const bf16_t*)p->RO, DM, p->Wt_up, DM, DM, pm * 256, pn * 256, shm, epi, wv); }
      GSYNC();
    }
    {
      fixup_phase(p, wv, l, last);
      GSYNC();
    }
    { const int nM = last ? 64 : 72;
      for (int i = blockIdx.x; i < nM * 8; i += G) { int pm, pn, qm = -1, qn = -1; tile_map(i, nM, 8, pm, pn, 4); if (last) pm = (pm >> 3) * 9 + 1 + (pm & 7);
        if (i + G < nM * 8) { tile_map(i + G, nM, 8, qm, qn, 4); if (last) qm = (qm >> 3) * 9 + 1 + (qm & 7); }
        const bool pre = i != (int)blockIdx.x; const int nr = qm < 0 ? -1 : qm * 256, nc = qn * 256;
        const int b = pm / 9; const bool isctx = (pm % 9) == 0;
        if (l == 0) {
          EpiOut epi; epi.base = p->X; epi.base_row0 = 0; epi.X = p->X; epi.gate = p->mod + (size_t)(isctx ? 8 : b) * NMOD + 5 * DM;
          epi.n2g = p->norm1_g + DM; epi.scl = p->mod + (size_t)(9 + (isctx ? 8 : b)) * NMOD + 1 * DM; epi.H2 = p->H; epi.ssq = (float*)(p->ctl + SSQ_WORD) + (size_t)2 * NROWS;
          gemm_tile(p->U, DFF, p->Wt_down, DFF, DFF, pm * 256, pn * 256, shm, epi, wv, pre, nr, nc);
        } else {
          EpiRes epi; epi.base = p->X; epi.base_row0 = 0; epi.X = p->X; epi.gate = p->mod + (size_t)(l * 9 + (isctx ? 8 : b)) * NMOD + 5 * DM;
          gemm_tile(p->U, DFF, p->Wt_down, DFF, DFF, pm * 256, pn * 256, shm, epi, wv, pre, nr, nc);
        } }
      if (l == 0) conv_phase(p, wv, 1, shm, 0, CV_IN + CV_OUT + CV_UP, (nM * 8) % G ? (nM * 8) % G : 0); }
    GSYNC();
  }

__global__ void __launch_bounds__(NTHR) mega(Params pk) {
  extern __shared__ __attribute__((aligned(16))) char shm[];
  __shared__ uint4 xb_words;
  cg::grid_group grid = cg::this_grid();
  KP p = relaunder((KP)__builtin_amdgcn_kernarg_segment_ptr());
  const int wv = __builtin_amdgcn_readfirstlane((int)(threadIdx.x >> 6));
  if (threadIdx.x == 0) xb_words = make_uint4(0u, 0u, 0u, 0u);
  __syncthreads();
  const XcdBarrier xbar = xcd_barrier_post(p->ctl, (volatile LAS unsigned*)&xb_words);
#define GSYNC() xcd_barrier(xbar)
  layer_body<0>(p, wv, shm, grid, xbar, (volatile LAS unsigned*)&xb_words);
  layer_body<1>(p, wv, shm, grid, xbar, (volatile LAS unsigned*)&xb_words);
  final_phase(p, wv);
}

static inline size_t al256(size_t x) { return (x + 255) & ~(size_t)255; }
extern "C" void kernel_launch(void* const* d_in, const int* in_sizes, int n_in, void* d_out, int out_size, void* d_ws, size_t ws_size, hipStream_t stream) {
  static int grid_blocks = 0;
  if (!grid_blocks) {
    int dev = 0, cus = 0, per_cu = 0;
    hipGetDevice(&dev);
    hipDeviceGetAttribute(&cus, hipDeviceAttributeMultiprocessorCount, dev);
    if (hipFuncSetAttribute((const void*)mega, hipFuncAttributeMaxDynamicSharedMemorySize, SHM_BYTES) != hipSuccess) fprintf(stderr, "hipFuncSetAttribute failed\n");
    hipOccupancyMaxActiveBlocksPerMultiprocessor(&per_cu, mega, NTHR, SHM_BYTES);
    if (per_cu < 1) { fprintf(stderr, "occupancy query returned %d\n", per_cu); per_cu = 1; }
    if (per_cu > 1) per_cu = 1;
    grid_blocks = cus * per_cu;
  }
  Params p{};
  const float* const* in = (const float* const*)d_in;
  p.x = in[0]; p.c = in[1]; p.ctx = in[2]; p.c_ctx = in[3]; p.ada_w = in[4]; p.ada_b = in[5]; p.norm1_g = in[6]; p.w_in = in[7];
  p.q_norm_g = in[8]; p.k_norm_g = in[9]; p.ret_log_decay = in[10]; p.ret_norm_g = in[11]; p.gla_gate_up = in[12]; p.gla_gate_b = in[13];
  p.gla_norm_g = in[14]; p.w_out = in[15]; p.norm2_g = in[16]; p.w_up = in[17]; p.conv_w = in[18]; p.conv_b = in[19]; p.w_down = in[20]; p.final_norm_g = in[21];
  p.out = (float*)d_out;
  char* w = (char*)d_ws; size_t off = 0;
  auto take = [&](size_t bytes) { char* r = w + off; off = al256(off + bytes); return r; };
  p.Wt_in = (bf16_t*)take((size_t)ZLD * DM * 2);
  p.Wt_out = (bf16_t*)take((size_t)DM * DM * 2);
  p.Wt_up = (bf16_t*)take((size_t)2 * DFF * DM * 2);
  p.Wt_down = (bf16_t*)take((size_t)DM * DFF * 2);
  p.mod = (float*)take((size_t)2 * 9 * NMOD * 4);
  p.X = (float*)take((size_t)NROWS * DM * 4);
  p.H = (bf16_t*)take((size_t)NROWS * DM * 2);
  p.HA = (float*)take((size_t)72 * 2 * DFF * 4);
  p.HB = (float*)take((size_t)72 * 2 * DFF * 2 * 4);
  p.ctl = (unsigned*)take((size_t)CTL_WORDS * 4);
  p.sW = (float*)take((size_t)2 * 9 * 2 * DFF * 4);
  p.sWin = (float*)take((size_t)9 * ZLD * 4);
  p.Kc = (bf16_t*)take((size_t)NB * 2 * RPB * 128 * 2);
  p.Vc = (bf16_t*)take((size_t)NB * 2 * RPB * 128 * 2);
  const size_t roff = off;
  p.Z = (bf16_t*)take((size_t)NROWS * ZLD * 2);
  p.GQt = (bf16_t*)take((size_t)2 * NROWS * 256 * 2);
  p.GKt = (bf16_t*)take((size_t)2 * NROWS * 256 * 2);
  p.Eend = (float*)take((size_t)2 * (NROWS / 64) * 256 * 4);
  p.RO = (bf16_t*)take((size_t)2 * NROWS * 512 * 2);
  p.GO = (bf16_t*)take((size_t)2 * NROWS * 512 * 2);
  p.U = (bf16_t*)(w + roff);
  if (off > ws_size) { fprintf(stderr, "workspace too small: need %zu have %zu\n", off, ws_size); return; }
  if (hipMemsetAsync(p.ctl, 0, (size_t)CTL_WORDS * 4, stream) != hipSuccess) fprintf(stderr, "memset failed\n");
  void* args[] = {&p};
  hipError_t e = hipLaunchCooperativeKernel((void*)mega, dim3(grid_blocks), dim3(NTHR), args, SHM_BYTES, stream);
  if (e != hipSuccess) fprintf(stderr, "cooperative launch failed: %s (grid %d)\n", hipGetErrorString(e), grid_blocks);
}
```

```cpp
#include <hip/hip_runtime.h>
#include <hip/hip_bf16.h>
#include <hip/hip_cooperative_groups.h>
#include <cstdio>
#include <cstdint>
namespace cg = cooperative_groups;

#ifndef PROBE
#define PROBE 0
#endif
#define REPS(bit) (((PROBE) >> (bit)) & 1 ? 2 : 1)
typedef unsigned short bf16_t;
using bf16x8 = __attribute__((ext_vector_type(8))) short;
using s16x4  = __attribute__((ext_vector_type(4))) short;
using f32x4  = __attribute__((ext_vector_type(4))) float;
using f32x16 = __attribute__((ext_vector_type(16))) float;
using u32x4  = __attribute__((ext_vector_type(4))) unsigned;
using u32x2  = __attribute__((ext_vector_type(2))) unsigned;

constexpr int NB = 8, SEQ = 2048, CTX = 256, DM = 2048, DFF = 5632, NIN = 5152;
constexpr int RPB = SEQ + CTX;
constexpr int NROWS = NB * RPB;
constexpr int ZLD = 5376;
constexpr int NMOD = 6 * DM;
constexpr int C_AQ = 0, C_AK = 1024, C_AV = 1280, C_RQ = 1536, C_RK = 2048, C_RV = 2560, C_RG = 3072,
              C_GQ = 3584, C_GK = 3840, C_GV = 4096, C_GR = 4608, C_GA = 5120;
constexpr float EPS = 1e-6f;
constexpr int NTHR = 512;
constexpr int SHM_BYTES = 139264;

struct Params {
  const float *x, *c, *ctx, *c_ctx, *ada_w, *ada_b, *norm1_g, *w_in, *q_norm_g, *k_norm_g, *ret_log_decay, *ret_norm_g,
      *gla_gate_up, *gla_gate_b, *gla_norm_g, *w_out, *norm2_g, *w_up, *conv_w, *conv_b, *w_down, *final_norm_g;
  float* out;
  bf16_t *Wt_in, *Wt_out, *Wt_up, *Wt_down;
  float* mod;
  float* X;
  bf16_t* H;
  bf16_t* Z;
  bf16_t* U;
  bf16_t* GQt;
  bf16_t* GKt;
  float* Eend;
  bf16_t* RO;
  bf16_t* GO;
  float* HA;
  float* HB;
  unsigned* ctl;
  float* sW;
  float* sWin;
  bf16_t* Kc;
  bf16_t* Vc;
};

typedef const __attribute__((address_space(4))) Params* KP;
__device__ __forceinline__ KP relaunder(KP p) { asm volatile("" : "+s"(p)); return p; }

__device__ __forceinline__ float bf2f(bf16_t h) { return __uint_as_float((unsigned)h << 16); }
__device__ __forceinline__ bf16_t f2bf(float f) { unsigned u = __float_as_uint(f); u += 0x7fffu + ((u >> 16) & 1u); return (bf16_t)(u >> 16); }
__device__ __forceinline__ unsigned cvtpk_asm(float lo, float hi) { unsigned r; asm volatile("v_cvt_pk_bf16_f32 %0, %1, %2" : "=v"(r) : "v"(lo), "v"(hi)); return r; }
typedef __bf16 bf16v2_t __attribute__((ext_vector_type(2)));
typedef float f32v2_t __attribute__((ext_vector_type(2)));
__device__ __forceinline__ unsigned cvtpk(float lo, float hi) { const f32v2_t v = {lo, hi}; const bf16v2_t b = __builtin_convertvector(v, bf16v2_t); return __builtin_bit_cast(unsigned, b); }
template <int X> __device__ __forceinline__ float swz_xor(float v) { return __int_as_float(__builtin_amdgcn_ds_swizzle(__float_as_int(v), (X << 10) | 0x1F)); }
__device__ __forceinline__ float wave_sum(float v) {
  v += swz_xor<16>(v); v += swz_xor<8>(v); v += swz_xor<4>(v); v += swz_xor<2>(v); v += swz_xor<1>(v);
  auto rr = __builtin_amdgcn_permlane32_swap(__float_as_uint(v), __float_as_uint(v), false, false);
  return __uint_as_float(rr[0]) + __uint_as_float(rr[1]);
}
__device__ __forceinline__ int otid(int wv) { unsigned z = 0u; asm volatile("" : "+v"(z)); return (wv << 6) | (int)__builtin_amdgcn_mbcnt_hi(~0u, __builtin_amdgcn_mbcnt_lo(~0u, z)); }
__device__ __forceinline__ float silu_f(float x) { return x * __builtin_amdgcn_rcpf(1.f + __builtin_amdgcn_exp2f(-1.4426950408889634f * x)); }
__device__ __forceinline__ float fexp(float x) { return __builtin_amdgcn_exp2f(1.4426950408889634f * x); }

#define XB_TMO      128
#define XB_XCNT(j)  (256  + 64 * (j))
#define XB_XSUB(j)  (1280 + 64 * (j))
#define XB_XGEN(j)  (2304 + 64 * (j))
#define XB_TOP      3328
#define XB_TOPGEN   3392
#define XCD_BAR_WORDS 3456
#define WQ_WORD(l, x) (XCD_BAR_WORDS + 64 * ((l) * 8 + (x)))
#define SSQ_WORD (XCD_BAR_WORDS + 64 * 16)
#define FSQ_WORD (SSQ_WORD + 3 * 18432)
#define FCN_WORD (FSQ_WORD + 18432)
#define CTL_WORDS (FCN_WORD + 72 * 64)
#define CTL_WORDS_OLD (SSQ_WORD + 3 * 18432)
#define XB_SPIN_CAP (1u << 22)
#define LAS __attribute__((address_space(3)))
__device__ __forceinline__ unsigned xb_ld(unsigned* p)              { return __hip_atomic_load(p, __ATOMIC_RELAXED, __HIP_MEMORY_SCOPE_AGENT); }
__device__ __forceinline__ unsigned xb_add(unsigned* p, unsigned v) { return __hip_atomic_fetch_add(p, v, __ATOMIC_RELAXED, __HIP_MEMORY_SCOPE_AGENT); }
__device__ __forceinline__ unsigned xb_xcc_id() { return (unsigned)__builtin_amdgcn_s_getreg((3 << 11) | 20) & 0xFu; }
#define XB_SPIN(cond, bar) do { unsigned _sp = 0; while (cond) { __builtin_amdgcn_s_sleep(1); \
    if ((++_sp & 255u) == 0u) { if (xb_ld(&(bar)[XB_TMO])) break; if (_sp > XB_SPIN_CAP) { atomicAdd(&(bar)[XB_TMO], 1u); break; } } } } while (0)
struct XcdBarrier { unsigned* bar; unsigned x; volatile LAS unsigned* st; };
__device__ __forceinline__ XcdBarrier xcd_barrier_post(unsigned* bar, volatile LAS unsigned* st) {
  XcdBarrier b; b.bar = bar; b.x = xb_xcc_id(); b.st = st;
  if (threadIdx.x == 0) (void)xb_add(&bar[XB_XCNT(b.x)], 1u);
  return b;
}
__device__ __forceinline__ void xcd_barrier_complete(unsigned* bar, unsigned x, unsigned& nloc, unsigned& nx) {
  const unsigned G = gridDim.x * gridDim.y * gridDim.z;
  unsigned sum, cnt, mine, sp = 0u;
  for (;;) {
    sum = 0u; cnt = 0u; mine = 0u;
#pragma unroll
    for (unsigned j = 0; j < 16; ++j) { const unsigned c = xb_ld(&bar[XB_XCNT(j)]); sum += c; cnt += (c > 0u) ? 1u : 0u; mine = (j == x) ? c : mine; }
    if (sum == G) break;
    __builtin_amdgcn_s_sleep(1);
    if ((++sp & 255u) == 0u) { if (xb_ld(&bar[XB_TMO])) break; if (sp > XB_SPIN_CAP) { atomicAdd(&bar[XB_TMO], 1u); break; } }
  }
  nloc = mine > 0u ? mine : 1u; nx = cnt > 0u ? cnt : 1u;
}
__device__ __forceinline__ void xcd_barrier(const XcdBarrier& b) {
  asm volatile("s_waitcnt vmcnt(0)" ::: "memory");
  __syncthreads();
  if (threadIdx.x == 0) {
    unsigned* bar = b.bar;
    __builtin_amdgcn_s_waitcnt(0);
    unsigned nloc = b.st[0], nx = b.st[1];
    if (nloc == 0u) { xcd_barrier_complete(bar, b.x, nloc, nx); b.st[0] = nloc; b.st[1] = nx; }
    const unsigned old = xb_add(&bar[XB_XSUB(b.x)], 1u);
    const unsigned gen = old / nloc;
    if (old + 1u == (gen + 1u) * nloc) {
      __builtin_amdgcn_fence(__ATOMIC_RELEASE, "agent");
      asm volatile("s_waitcnt vmcnt(0)" ::: "memory");
      const unsigned og = xb_add(&bar[XB_TOP], 1u);
      const unsigned tg = og / nx;
      if (og + 1u == (tg + 1u) * nx) xb_add(&bar[XB_TOPGEN], 1u);
      else XB_SPIN(xb_ld(&bar[XB_TOPGEN]) == tg, bar);
      __builtin_amdgcn_fence(__ATOMIC_ACQUIRE, "agent");
      xb_add(&bar[XB_XGEN(b.x)], 1u);
      asm volatile("s_waitcnt vmcnt(0)" ::: "memory");
    } else {
      XB_SPIN(xb_ld(&bar[XB_XGEN(b.x)]) == gen, bar);
      __builtin_amdgcn_fence(__ATOMIC_ACQUIRE, "agent");
      asm volatile("s_waitcnt vmcnt(0)" ::: "memory");
    }
  }
  __syncthreads();
}

constexpr int CV_IN = 42 * 32, CV_OUT = 16 * 32, CV_UP = 88 * 32, CV_DOWN = 16 * 88, CV_TOTAL = CV_IN + CV_OUT + CV_UP + CV_DOWN;
struct CvUnit { const float* src; bf16_t* dst; int K, N, k0, n0, perm; };
__device__ __forceinline__ CvUnit cv_decode(KP p, int l, int u) {
  CvUnit c;
  if (u < CV_IN) { c.src = p->w_in + (size_t)l * DM * NIN; c.dst = p->Wt_in; c.K = DM; c.N = NIN; c.k0 = (u / 42) * 64; c.n0 = (u % 42) * 128; c.perm = 0; }
  else if (u < CV_IN + CV_OUT) { const int v = u - CV_IN; c.src = p->w_out + (size_t)l * DM * DM; c.dst = p->Wt_out; c.K = DM; c.N = DM; c.k0 = (v / 16) * 64; c.n0 = (v % 16) * 128; c.perm = 0; }
  else if (u < CV_IN + CV_OUT + CV_UP) { const int v = u - CV_IN - CV_OUT; c.src = p->w_up + (size_t)l * DM * 2 * DFF; c.dst = p->Wt_up; c.K = DM; c.N = 2 * DFF; c.k0 = (v / 88) * 64; c.n0 = (v % 88) * 128; c.perm = 1; }
  else { const int v = u - CV_IN - CV_OUT - CV_UP; c.src = p->w_down + (size_t)l * DFF * DM; c.dst = p->Wt_down; c.K = DFF; c.N = DM; c.k0 = (v / 16) * 64; c.n0 = (v % 16) * 128; c.perm = 0; }
  return c;
}
__device__ __forceinline__ void conv_phase(KP p, int wv, int l, char* lds, const int u_lo, const int u_hi, const int bstart) {
  p = relaunder(p);
  float* tile = (float*)lds;
  const int tid = otid(wv);
  const int lk = tid >> 5, ln = (tid & 31) * 4;
  const int sn = tid >> 2, sk = (tid & 3) * 16;
  if ((int)blockIdx.x < bstart) return;
  const int ustride = (int)gridDim.x - bstart;
  int u = u_lo + (int)blockIdx.x - bstart;
  if (u >= u_hi) return;
  CvUnit c = cv_decode(p, l, u);
  f32x4 r[4];
#define CVLOAD() do { _Pragma("unroll") for (int i = 0; i < 4; ++i) { r[i] = (f32x4){0.f, 0.f, 0.f, 0.f}; \
    if (c.n0 + ln < c.N) r[i] = __builtin_nontemporal_load((const f32x4*)(c.src + (size_t)(c.k0 + lk + 16 * i) * c.N + c.n0 + ln)); } } while (0)
  CVLOAD();
  for (;;) {
#pragma unroll
    for (int i = 0; i < 4; ++i) {
#pragma unroll
      for (int j = 0; j < 4; ++j) tile[(lk + 16 * i) * 129 + ln + j] = r[i][j];
    }
    const CvUnit cur = c;
    const int un = u + ustride; const bool more = un < u_hi;
    if (more) { c = cv_decode(p, l, un); CVLOAD(); }
    __syncthreads();
    {
      int drow = cur.n0 + sn;
      if (cur.perm) { const bool isv = cur.n0 >= DFF; const int j0 = isv ? cur.n0 - DFF : cur.n0; drow = (j0 >> 7) * 256 + (isv ? 128 : 0) + sn; }
      u32x4 w0, w1;
#pragma unroll
      for (int q = 0; q < 4; ++q) w0[q] = cvtpk(tile[(sk + 2 * q) * 129 + sn], tile[(sk + 2 * q + 1) * 129 + sn]);
#pragma unroll
      for (int q = 0; q < 4; ++q) w1[q] = cvtpk(tile[(sk + 8 + 2 * q) * 129 + sn], tile[(sk + 8 + 2 * q + 1) * 129 + sn]);
      bf16_t* dp = cur.dst + (size_t)drow * cur.K + cur.k0 + sk;
      *(u32x4*)dp = w0; *(u32x4*)(dp + 8) = w1;
    }
    __syncthreads();
    if (!more) break;
    u = un;
  }
#undef CVLOAD
}

template <int MODE>
__device__ __forceinline__ void gemv9_unit(KP p, int wv, int u, int l1, char* lds) {
  p = relaunder(p);
  const int tid = otid(wv);
  const int l = MODE == 0 ? u / 384 : l1, n0 = (MODE == 0 ? (u % 384) : u) * 32;
  const int NW_ = MODE == 0 ? NMOD : MODE == 1 ? 2 * DFF : NIN;
  if (MODE == 2 && n0 >= NIN) { if (tid < 288) p->sWin[(size_t)(tid >> 5) * ZLD + n0 + (tid & 31)] = 0.f; return; }
  float* sc = (float*)lds;
  for (int i = tid; i < 9 * 2048; i += NTHR) { const int r = i >> 11, k = i & 2047;
    if (MODE == 0) { const float v = (r < 8) ? p->c[r * 2048 + k] : p->c_ctx[k]; sc[i] = silu_f(v); }
    else sc[i] = p->mod[(size_t)(l * 9 + r) * NMOD + (MODE == 1 ? 3 : 0) * DM + k]; }
  __syncthreads();
  const int kg = tid >> 3, cq = tid & 7;
  const float* w = (MODE == 0 ? p->ada_w + (size_t)l * DM * NMOD : MODE == 1 ? p->w_up + (size_t)l * DM * 2 * DFF : p->w_in + (size_t)l * DM * NIN) + (size_t)(kg * 32) * NW_ + n0 + cq * 4;
  f32x4 acc[9];
#pragma unroll
  for (int r = 0; r < 9; ++r) acc[r] = (f32x4){0.f, 0.f, 0.f, 0.f};
#pragma unroll
  for (int kb = 0; kb < 32; kb += 16) {
    f32x4 wv4[16];
#pragma unroll
    for (int j = 0; j < 16; ++j) wv4[j] = __builtin_nontemporal_load((const f32x4*)(w + (size_t)(kb + j) * NW_));
#pragma unroll
    for (int r = 0; r < 9; ++r) {
#pragma unroll
      for (int j4 = 0; j4 < 4; ++j4) {
        const f32x4 s = *(const f32x4*)&sc[r * 2048 + kg * 32 + kb + j4 * 4];
        acc[r] += wv4[j4 * 4 + 0] * s[0] + wv4[j4 * 4 + 1] * s[1] + wv4[j4 * 4 + 2] * s[2] + wv4[j4 * 4 + 3] * s[3];
      }
    }
  }
  __syncthreads();
  float* red = sc;
#pragma unroll
  for (int r = 0; r < 9; ++r) *(f32x4*)&red[(kg * 9 + r) * 32 + cq * 4] = acc[r];
  __syncthreads();
  if (tid < 288) {
    const int r = tid >> 5, cc = tid & 31; float s = MODE == 0 ? p->ada_b[l * NMOD + n0 + cc] : 0.f;
#pragma unroll 8
    for (int g = 0; g < 64; ++g) s += red[(g * 9 + r) * 32 + cc];
    if (MODE == 0) p->mod[(size_t)(l * 9 + r) * NMOD + n0 + cc] = s;
    else if (MODE == 2) p->sWin[(size_t)r * ZLD + n0 + cc] = s;
    else { const int n = n0 + cc, j = n < DFF ? n : n - DFF; p->sW[(size_t)(l * 9 + r) * (2 * DFF) + (j >> 7) * 256 + (n < DFF ? 0 : 128) + (j & 127)] = s; }
  }
  __syncthreads();
}

__device__ __forceinline__ void norm_phase(KP p, int wv, int l, int which, bool from_inputs, bool skip_ctx) {
  p = relaunder(p);
  const int tid_ = otid(wv); const int wid = wv, lane = tid_ & 63;
  const float* g = (which ? p->norm2_g : p->norm1_g) + l * DM;
  for (int row0 = (blockIdx.x * 8 + wid) * 2; row0 < NROWS; row0 += gridDim.x * 16) {
    const float* xr[2]; const float* mrow[2];
#pragma unroll
    for (int q = 0; q < 2; ++q) { const int row = row0 + q, b = row / RPB, rb = row % RPB; const bool isctx = rb < CTX;
      xr[q] = from_inputs ? (isctx ? p->ctx + (size_t)(b * CTX + rb) * DM : p->x + (size_t)(b * SEQ + rb - CTX) * DM) : p->X + (size_t)row * DM;
      mrow[q] = p->mod + (size_t)(l * 9 + (isctx ? 8 : b)) * NMOD + (which ? 3 : 0) * DM; }
    f32x4 v[2][8];
#pragma unroll
    for (int q = 0; q < 2; ++q)
#pragma unroll
      for (int i = 0; i < 8; ++i) v[q][i] = *(const f32x4*)(xr[q] + i * 256 + lane * 4);
#pragma unroll
    for (int q = 0; q < 2; ++q) {
      const int row = row0 + q;
      if (skip_ctx && (row % RPB) < CTX) continue;
      float ss = 0.f;
#pragma unroll
      for (int i = 0; i < 8; ++i) ss += v[q][i][0] * v[q][i][0] + v[q][i][1] * v[q][i][1] + v[q][i][2] * v[q][i][2] + v[q][i][3] * v[q][i][3];
      ss = wave_sum(ss);
      const float r = rsqrtf(ss * (1.f / DM) + EPS);
#pragma unroll
      for (int i = 0; i < 8; ++i) {
        const int col = i * 256 + lane * 4;
        const f32x4 gg = *(const f32x4*)(g + col), sh = *(const f32x4*)(mrow[q] + col), sc = *(const f32x4*)(mrow[q] + DM + col);
        const f32x4 o = (v[q][i] * r * gg) * (sc + 1.f) + sh;
        u32x2 w; w[0] = cvtpk(o[0], o[1]); w[1] = cvtpk(o[2], o[3]);
        *(u32x2*)(p->H + (size_t)row * DM + col) = w;
      }
    }
  }
}

namespace g8 {
constexpr int BM = 256, BK = 64, HALF = 128, HT = HALF * BK;
__device__ __forceinline__ int lds_byte(int r, int c) { const int st = (r >> 4) * 2 + (c >> 5), rr = r & 15, cc = c & 31, ob = rr * 64 + cc * 2; return st * 1024 + (ob ^ (((ob >> 9) & 1) << 5)); }
__device__ __forceinline__ void stage_rc(int b, int& R, int& C) { const int st = b / 1024, sb = b % 1024, swz = sb ^ (((sb >> 9) & 1) << 5); R = (st >> 1) * 16 + swz / 64; C = (st & 1) * 32 + (swz % 64) / 2; }
}
typedef __attribute__((address_space(3))) unsigned lds_u32;

template <class Epi>
__device__ __forceinline__ void gemm_tile(const bf16_t* __restrict__ A, const int lda, const bf16_t* __restrict__ Bt, const int ldb, const int K,
                                          const int brow, const int bcol, char* shmc, Epi& epi, const int wv, const bool pre = false, const int nbrow = -1, const int nbcol = -1) {
  using namespace g8;
  typedef __attribute__((address_space(3))) unsigned char lds_u8;
  lds_u8* lds = (lds_u8*)shmc;
  const int tid = otid(wv);
  const int wid = wv, lane = tid & 63, wr = wid >> 2, wc = wid & 3, fr = lane & 15, fq = lane >> 4;
  constexpr int HTB = HT * 2;
  unsigned voffA[2], voffB[2];
#pragma unroll
  for (int i = 0; i < 2; ++i) { int R, C; stage_rc(tid * 16 + i * 8192, R, C); voffA[i] = (unsigned)(R * lda + C) * 2u; voffB[i] = (unsigned)(R * ldb + C) * 2u; }
  const size_t kstep = (size_t)(BK * 2);
  const size_t hstepA = (size_t)HALF * lda * 2, hstepB = (size_t)HALF * ldb * 2;
  const unsigned ldsw = (unsigned)wid * 1024u;
  const int aoff = lds_byte(wr * 64 + fr, fq * 8), boff = lds_byte(wc * 32 + fr, fq * 8);
  const char* cA = (const char*)A + (size_t)brow * lda * 2; const char* cB = (const char*)Bt + (size_t)bcol * ldb * 2;
#define SA(b, h) (((b) * 2 + (h)) * HTB)
#define SB(b, h) ((4 + (b) * 2 + (h)) * HTB)
#define STAGE(bufoff, gbase, voff) do { _Pragma("unroll") for (int _i = 0; _i < 2; ++_i) \
    __builtin_amdgcn_global_load_lds((const unsigned*)((const char*)(gbase) + (voff)[_i]), (lds_u32*)(lds + (bufoff) + ldsw + _i * 8192), 16, 0, 0); } while (0)
#define LDA(dst, b, h) do { _Pragma("unroll") for (int m = 0; m < 4; ++m) _Pragma("unroll") for (int k = 0; k < 2; ++k) dst[m][k] = *(const __attribute__((address_space(3))) bf16x8*)(lds + SA(b, h) + aoff + m * 2048 + k * 1024); } while (0)
#define LDB(dst, b, h) do { _Pragma("unroll") for (int n = 0; n < 2; ++n) _Pragma("unroll") for (int k = 0; k < 2; ++k) dst[n][k] = *(const __attribute__((address_space(3))) bf16x8*)(lds + SB(b, h) + boff + n * 2048 + k * 1024); } while (0)
#define MMA(ai, bj, At_, Bt_) do { __builtin_amdgcn_s_setprio(1); _Pragma("unroll") for (int m = 0; m < 4; ++m) _Pragma("unroll") for (int n = 0; n < 2; ++n) _Pragma("unroll") for (int k = 0; k < 2; ++k) \
      acc[ai][bj][m][n] = __builtin_amdgcn_mfma_f32_16x16x32_bf16(Bt_[n][k], At_[m][k], acc[ai][bj][m][n], 0, 0, 0); __builtin_amdgcn_s_setprio(0); } while (0)
#define WAIT_V(n) asm volatile("s_waitcnt vmcnt(" #n ")" ::: "memory")
#define WAIT_L(n) asm volatile("s_waitcnt lgkmcnt(" #n ")" ::: "memory")
#define BAR __builtin_amdgcn_s_barrier()
#define SCHED __builtin_amdgcn_sched_barrier(0)
  f32x4 acc[2][2][4][2];
#pragma unroll
  for (int a = 0; a < 2; ++a)
#pragma unroll
    for (int b = 0; b < 2; ++b)
#pragma unroll
      for (int m = 0; m < 4; ++m)
#pragma unroll
        for (int n = 0; n < 2; ++n) acc[a][b][m][n] = (f32x4){0.f, 0.f, 0.f, 0.f};
  bf16x8 At[4][2], B0[2][2], B1[2][2];
  const int nt = K / BK;
  if (!pre) { STAGE(SB(0, 0), cB, voffB); STAGE(SA(0, 0), cA, voffA); STAGE(SB(0, 1), cB + hstepB, voffB); STAGE(SA(0, 1), cA + hstepA, voffA); }
  if (wr == 1) BAR;
  WAIT_V(4); BAR;
  STAGE(SB(1, 0), cB + kstep, voffB); STAGE(SA(1, 0), cA + kstep, voffA); STAGE(SB(1, 1), cB + hstepB + kstep, voffB);
  WAIT_V(6); BAR;
  for (int t = 0; t < nt - 2; t += 2) {
    const char* a1 = cA + (size_t)(t + 1) * kstep;
    const char* a2 = cA + (size_t)(t + 2) * kstep; const char* b2 = cB + (size_t)(t + 2) * kstep;
    const char* a3 = a2 + kstep; const char* b3 = b2 + kstep;
    LDB(B0, 0, 0); SCHED; LDA(At, 0, 0); STAGE(SA(1, 1), a1 + hstepA, voffA);
    WAIT_L(8); BAR; WAIT_L(0); MMA(0, 0, At, B0); BAR; SCHED;
    LDB(B1, 0, 1); STAGE(SB(0, 0), b2, voffB);
    BAR; WAIT_L(0); MMA(0, 1, At, B1); BAR;
    LDA(At, 0, 1); STAGE(SA(0, 0), a2, voffA);
    BAR; WAIT_L(0); MMA(1, 0, At, B0); BAR; SCHED;
    STAGE(SB(0, 1), b2 + hstepB, voffB);
    WAIT_V(6); BAR; MMA(1, 1, At, B1); BAR;
    LDB(B0, 1, 0); SCHED; LDA(At, 1, 0); STAGE(SA(0, 1), a2 + hstepA, voffA);
    WAIT_L(8); BAR; WAIT_L(0); MMA(0, 0, At, B0); BAR; SCHED;
    LDB(B1, 1, 1); STAGE(SB(1, 0), b3, voffB);
    BAR; WAIT_L(0); MMA(0, 1, At, B1); BAR;
    LDA(At, 1, 1); STAGE(SA(1, 0), a3, voffA);
    BAR; WAIT_L(0); MMA(1, 0, At, B0); BAR; SCHED;
    STAGE(SB(1, 1), b3 + hstepB, voffB);
    WAIT_V(6); BAR; MMA(1, 1, At, B1); BAR;
  }
  { const char* a1 = cA + (size_t)(nt - 1) * kstep;
    LDB(B0, 0, 0); LDA(At, 0, 0); STAGE(SA(1, 1), a1 + hstepA, voffA);
    BAR; WAIT_L(0); MMA(0, 0, At, B0); BAR;
    LDB(B1, 0, 1); BAR; WAIT_L(0); MMA(0, 1, At, B1); BAR;
    LDA(At, 0, 1); WAIT_V(4); BAR; WAIT_L(0); MMA(1, 0, At, B0); MMA(1, 1, At, B1); BAR; }
  { LDB(B0, 1, 0); LDA(At, 1, 0); WAIT_V(2); BAR; WAIT_L(0); MMA(0, 0, At, B0); BAR;
    LDB(B1, 1, 1); WAIT_V(0); BAR; WAIT_L(0); MMA(0, 1, At, B1); BAR;
    LDA(At, 1, 1); BAR; WAIT_L(0); MMA(1, 0, At, B0); MMA(1, 1, At, B1); BAR; }
  if (wr == 0) BAR;
  __syncthreads();
  __builtin_amdgcn_sched_barrier(0);
  if (nbrow >= 0) { const char* nA = (const char*)A + (size_t)nbrow * lda * 2; const char* nB = (const char*)Bt + (size_t)nbcol * ldb * 2;
    const int t2 = otid(wv); unsigned vA2[2], vB2[2];
#pragma unroll
    for (int i = 0; i < 2; ++i) { int R, C; stage_rc(t2 * 16 + i * 8192, R, C); vA2[i] = (unsigned)(R * lda + C) * 2u; vB2[i] = (unsigned)(R * ldb + C) * 2u; }
    STAGE(SB(0, 0), nB, vB2); STAGE(SA(0, 0), nA, vA2); STAGE(SB(0, 1), nB + hstepB, vB2); STAGE(SA(0, 1), nA + hstepA, vA2); }
  epi(acc, brow, bcol, wr, wc, fr, fq, shmc);
  __syncthreads();
#undef SA
#undef SB
#undef STAGE
#undef LDA
#undef LDB
#undef MMA
}

__device__ __forceinline__ void tile_map(int L, int nM, int nN, int& pm, int& pn, const int WGM = 8) {
  const int nwg = nM * nN; int wgid = L;
  { const int q = nwg / 8, r = nwg % 8, xcd = wgid % 8, off = wgid / 8; wgid = (xcd < r ? xcd * (q + 1) : r * (q + 1) + (xcd - r) * q) + off; }
  const int nig = WGM * nN, gid = wgid / nig, fm = gid * WGM, gsz = (nM - fm) < WGM ? (nM - fm) : WGM;
  pm = fm + ((wgid % nig) % gsz); pn = (wgid % nig) / gsz;
}

template <bool NORM>
struct EpiBf16 {
  bf16_t* O; int ldo; const float* ssq; const float* sWr;
  __device__ __forceinline__ void operator()(f32x4 (&acc)[2][2][4][2], int brow, int bcol, int wr, int wc, int fr, int fq, char*) const {
    if (NORM) {
      float rs[2][4];
#pragma unroll
      for (int ai = 0; ai < 2; ++ai)
#pragma unroll
        for (int m = 0; m < 4; ++m) rs[ai][m] = rsqrtf(ssq[brow + ai * 128 + wr * 64 + m * 16 + fr] * (1.f / DM) + EPS);
#pragma unroll
      for (int bj = 0; bj < 2; ++bj)
#pragma unroll
        for (int n = 0; n < 2; ++n) { const f32x4 sw = *(const f32x4*)(sWr + bcol + bj * 128 + wc * 32 + n * 16 + fq * 4);
#pragma unroll
          for (int ai = 0; ai < 2; ++ai)
#pragma unroll
            for (int m = 0; m < 4; ++m) acc[ai][bj][m][n] = acc[ai][bj][m][n] * rs[ai][m] + sw; }
    }
#pragma unroll
    for (int ai = 0; ai < 2; ++ai)
#pragma unroll
      for (int m = 0; m < 4; ++m) {
        bf16_t* rowp = O + (size_t)(brow + ai * 128 + wr * 64 + m * 16 + fr) * ldo + bcol + wc * 32 + fq * 4;
#pragma unroll
        for (int bj = 0; bj < 2; ++bj)
#pragma unroll
          for (int n = 0; n < 2; ++n) { const f32x4 a = acc[ai][bj][m][n]; u32x2 w; w[0] = cvtpk(a[0], a[1]); w[1] = cvtpk(a[2], a[3]); *(u32x2*)(rowp + bj * 128 + n * 16) = w; }
      }
  }
};
struct EpiRes {
  const float* base; long base_row0; float* X; const float* gate;
  __device__ __forceinline__ void operator()(f32x4 (&acc)[2][2][4][2], int brow, int bcol, int wr, int wc, int fr, int fq, char*) const {
    f32x4 g[2][2];
#pragma unroll
    for (int bj = 0; bj < 2; ++bj)
#pragma unroll
      for (int n = 0; n < 2; ++n) g[bj][n] = *(const f32x4*)(gate + bcol + bj * 128 + wc * 32 + n * 16 + fq * 4);
#pragma unroll
    for (int ai = 0; ai < 2; ++ai)
#pragma unroll
      for (int m = 0; m < 4; ++m) {
        if (m == 0 || m == 2) __builtin_amdgcn_sched_barrier(0);
        const long row = brow + ai * 128 + wr * 64 + m * 16 + fr; const int col0 = bcol + wc * 32 + fq * 4;
        const float* bp = base + (size_t)(row - base_row0) * DM + col0; float* xp = X + (size_t)row * DM + col0;
#pragma unroll
        for (int bj = 0; bj < 2; ++bj)
#pragma unroll
          for (int n = 0; n < 2; ++n) { const f32x4 bv = *(const f32x4*)(bp + bj * 128 + n * 16); *(f32x4*)(xp + bj * 128 + n * 16) = bv + g[bj][n] * acc[ai][bj][m][n]; }
      }
  }
};
struct EpiOut {
  const float* base; long base_row0; float* X; const float* gate; const float* n2g; const float* scl; bf16_t* H2; float* ssq;
  __device__ __forceinline__ void operator()(f32x4 (&acc)[2][2][4][2], int brow, int bcol, int wr, int wc, int fr, int fq, char*) const {
    f32x4 g[2][2], gm[2][2];
#pragma unroll
    for (int bj = 0; bj < 2; ++bj)
#pragma unroll
      for (int n = 0; n < 2; ++n) { const int col = bcol + bj * 128 + wc * 32 + n * 16 + fq * 4; g[bj][n] = *(const f32x4*)(gate + col); gm[bj][n] = *(const f32x4*)(n2g + col) * (*(const f32x4*)(scl + col) + 1.f); }
#pragma unroll
    for (int ai = 0; ai < 2; ++ai)
#pragma unroll
      for (int m = 0; m < 4; ++m) {
        const long row = brow + ai * 128 + wr * 64 + m * 16 + fr; const int col0 = bcol + wc * 32 + fq * 4;
        const float* bp = base + (size_t)(row - base_row0) * DM + col0; float* xp = X + (size_t)row * DM + col0; bf16_t* hp = H2 + (size_t)row * DM + col0;
        float ss = 0.f;
#pragma unroll
        for (int bj = 0; bj < 2; ++bj)
#pragma unroll
          for (int n = 0; n < 2; ++n) {
            const f32x4 xn = *(const f32x4*)(bp + bj * 128 + n * 16) + g[bj][n] * acc[ai][bj][m][n];
            *(f32x4*)(xp + bj * 128 + n * 16) = xn;
            ss += xn[0] * xn[0] + xn[1] * xn[1] + xn[2] * xn[2] + xn[3] * xn[3];
            const f32x4 hv = xn * gm[bj][n];
            u32x2 w; w[0] = cvtpk(hv[0], hv[1]); w[1] = cvtpk(hv[2], hv[3]);
            *(u32x2*)(hp + bj * 128 + n * 16) = w;
          }
        ss += swz_xor<16>(ss);
        { auto rr = __builtin_amdgcn_permlane32_swap(__float_as_uint(ss), __float_as_uint(ss), false, false); ss = __uint_as_float(rr[0]) + __uint_as_float(rr[1]); }
        if (fq == 0) (void)__hip_atomic_fetch_add(ssq + row, ss, __ATOMIC_RELAXED, __HIP_MEMORY_SCOPE_AGENT);
      }
  }
};
struct EpiFinal {
  const float* X; const float* gate; const float* fg; float* out; float* fsq; unsigned* cnt; unsigned* ctl;
  __device__ __forceinline__ void operator()(f32x4 (&acc)[2][2][4][2], int brow, int bcol, int wr, int wc, int fr, int fq, char*) const {
    const int tid = ((wr * 4 + wc) << 6) | (fq << 4) | fr;
    { f32x4 g[2][2];
#pragma unroll
      for (int bj = 0; bj < 2; ++bj)
#pragma unroll
        for (int n = 0; n < 2; ++n) g[bj][n] = *(const f32x4*)(gate + bcol + bj * 128 + wc * 32 + n * 16 + fq * 4);
#pragma unroll
      for (int ai = 0; ai < 2; ++ai)
#pragma unroll
        for (int m = 0; m < 4; ++m) {
          if (m == 0 || m == 2) __builtin_amdgcn_sched_barrier(0);
          const long row = brow + ai * 128 + wr * 64 + m * 16 + fr;
          const float* xp = X + (size_t)row * DM + bcol + wc * 32 + fq * 4;
          float ss = 0.f;
#pragma unroll
          for (int bj = 0; bj < 2; ++bj)
#pragma unroll
            for (int n = 0; n < 2; ++n) { const f32x4 xn = *(const f32x4*)(xp + bj * 128 + n * 16) + g[bj][n] * acc[ai][bj][m][n]; acc[ai][bj][m][n] = xn;
              ss += xn[0] * xn[0] + xn[1] * xn[1] + xn[2] * xn[2] + xn[3] * xn[3]; }
          ss += swz_xor<16>(ss);
          { auto rr = __builtin_amdgcn_permlane32_swap(__float_as_uint(ss), __float_as_uint(ss), false, false); ss = __uint_as_float(rr[0]) + __uint_as_float(rr[1]); }
          if (fq == 0) (void)__hip_atomic_fetch_add(fsq + row, ss, __ATOMIC_RELAXED, __HIP_MEMORY_SCOPE_AGENT);
        } }
    asm volatile("s_waitcnt vmcnt(0)" ::: "memory");
    __syncthreads();
    if (tid == 0) { (void)xb_add(cnt, 1u); XB_SPIN(xb_ld(cnt) < 8u, ctl); }
    __syncthreads();
    f32x4 fgv[2][2];
#pragma unroll
    for (int bj = 0; bj < 2; ++bj)
#pragma unroll
      for (int n = 0; n < 2; ++n) fgv[bj][n] = *(const f32x4*)(fg + bcol + bj * 128 + wc * 32 + n * 16 + fq * 4);
#pragma unroll
    for (int ai = 0; ai < 2; ++ai)
#pragma unroll
      for (int m = 0; m < 4; ++m) {
        const int rl = ai * 128 + wr * 64 + m * 16 + fr;
        const float r = rsqrtf(__hip_atomic_load(fsq + brow + rl, __ATOMIC_RELAXED, __HIP_MEMORY_SCOPE_AGENT) * (1.f / DM) + EPS);
        float* op = out + (size_t)rl * DM + bcol + wc * 32 + fq * 4;
#pragma unroll
        for (int bj = 0; bj < 2; ++bj)
#pragma unroll
          for (int n = 0; n < 2; ++n) __builtin_nontemporal_store(acc[ai][bj][m][n] * r * fgv[bj][n], (f32x4*)(op + bj * 128 + n * 16));
      }
  }
};
struct EpiUp {
  const float* cw; const float* cb; bf16_t* U; float* HA; float* HB; int pm, pn; const float* ssq; const float* sWr;
  __device__ __forceinline__ void operator()(f32x4 (&acc)[2][2][4][2], int brow, int bcol, int wr, int wc, int fr, int fq, char* lds) const {
    constexpr int AST = 272;
    { float rs[2][4];
#pragma unroll
      for (int ai = 0; ai < 2; ++ai)
#pragma unroll
        for (int m = 0; m < 4; ++m) rs[ai][m] = rsqrtf(ssq[brow + ai * 128 + wr * 64 + m * 16 + fr] * (1.f / DM) + EPS);
#pragma unroll
      for (int bj = 0; bj < 2; ++bj)
#pragma unroll
        for (int n = 0; n < 2; ++n) { const f32x4 sw = *(const f32x4*)(sWr + bcol + bj * 128 + wc * 32 + n * 16 + fq * 4);
#pragma unroll
          for (int ai = 0; ai < 2; ++ai)
#pragma unroll
            for (int m = 0; m < 4; ++m) acc[ai][bj][m][n] = acc[ai][bj][m][n] * rs[ai][m] + sw; } }
#pragma unroll
    for (int ai = 0; ai < 2; ++ai)
#pragma unroll
      for (int m = 0; m < 4; ++m)
#pragma unroll
        for (int n = 0; n < 2; ++n) { const f32x4 a = acc[ai][0][m][n]; u32x2 w; w[0] = cvtpk(a[0], a[1]); w[1] = cvtpk(a[2], a[3]);
          *(u32x2*)(lds + (ai * 128 + wr * 64 + m * 16 + fr) * AST + (wc * 32 + n * 16 + fq * 4) * 2) = w; }
    __syncthreads();
    f32x4 w0[2], w1[2], w2[2], bb[2];
#pragma unroll
    for (int n = 0; n < 2; ++n) { const int f = pn * 128 + wc * 32 + n * 16 + fq * 4;
      w0[n] = *(const f32x4*)(cw + f); w1[n] = *(const f32x4*)(cw + DFF + f); w2[n] = *(const f32x4*)(cw + 2 * DFF + f); bb[n] = *(const f32x4*)(cb + f); }
#pragma unroll
    for (int ai = 0; ai < 2; ++ai)
#pragma unroll
      for (int m = 0; m < 4; ++m) {
        const int rl = ai * 128 + wr * 64 + m * 16 + fr;
#pragma unroll
        for (int n = 0; n < 2; ++n) {
          const int c = wc * 32 + n * 16 + fq * 4;
          f32x4 up = {0.f, 0.f, 0.f, 0.f}, dn = {0.f, 0.f, 0.f, 0.f};
          if (rl > 0) { const u32x2 r = *(const u32x2*)(lds + (rl - 1) * AST + c * 2); up[0] = __uint_as_float(r[0] << 16); up[1] = __uint_as_float(r[0] & 0xffff0000u); up[2] = __uint_as_float(r[1] << 16); up[3] = __uint_as_float(r[1] & 0xffff0000u); }
          if (rl < 255) { const u32x2 r = *(const u32x2*)(lds + (rl + 1) * AST + c * 2); dn[0] = __uint_as_float(r[0] << 16); dn[1] = __uint_as_float(r[0] & 0xffff0000u); dn[2] = __uint_as_float(r[1] << 16); dn[3] = __uint_as_float(r[1] & 0xffff0000u); }
          const f32x4 a = acc[ai][0][m][n], v = acc[ai][1][m][n];
          const f32x4 cv = up * w0[n] + a * w1[n] + dn * w2[n] + bb[n];
          float u[4];
#pragma unroll
          for (int j = 0; j < 4; ++j) u[j] = silu_f(cv[j]) * v[j];
          u32x2 w; w[0] = cvtpk(u[0], u[1]); w[1] = cvtpk(u[2], u[3]);
          const int f = pn * 128 + c;
          *(u32x2*)(U + (size_t)(brow + rl) * DFF + f) = w;
          if (rl == 0 || rl == 255) {
            const int e = rl == 0 ? 0 : 1;
            *(f32x4*)(HA + ((size_t)(pm * 2 + e)) * DFF + f) = a;
            float* hb = HB + (((size_t)(pm * 2 + e)) * DFF + f) * 2;
            *(f32x4*)(hb) = (f32x4){cv[0], v[0], cv[1], v[1]};
            *(f32x4*)(hb + 4) = (f32x4){cv[2], v[2], cv[3], v[3]};
          }
        }
      }
  }
};

namespace at {
constexpr int D = 128, NW = 8, QBLK = 32, KVBLK = 64;
constexpr float SCALE = 0.088388347648318440f;
constexpr float THR = 8.f;
constexpr int LDQ = ZLD, LDK = 128, LDO = DM;
constexpr size_t SHM_V = KVBLK * D * 2, SHM_K = KVBLK * D * 2;
#define KSWZ(row, colB) ((row) * 256 + ((colB) ^ (((row) & 7) << 4)))
#define SBAR() __builtin_amdgcn_sched_barrier(0)
__device__ __forceinline__ int crow(int r, int hi) { return (r & 3) + 8 * (r >> 2) + 4 * hi; }
__device__ __forceinline__ void partialSM(f32x16& p0, f32x16& p1, float& m_reg, float& mn, float& alpha) {
  constexpr float C = SCALE * 1.4426950408889634f;
  float pmax = p0[0]; for (int r = 1; r < 16; ++r) pmax = fmaxf(pmax, p0[r]); for (int r = 0; r < 16; ++r) pmax = fmaxf(pmax, p1[r]);
  { auto rr = __builtin_amdgcn_permlane32_swap(__float_as_uint(pmax), __float_as_uint(pmax), false, false);
    pmax = fmaxf(__uint_as_float(rr[0]), __uint_as_float(rr[1])); }
  if (__builtin_expect(__all(pmax - m_reg <= THR / SCALE), 1)) { mn = m_reg; alpha = 1.f; }
  else { mn = fmaxf(m_reg, pmax); alpha = __builtin_amdgcn_exp2f((m_reg - mn) * C); m_reg = mn; }
  float mnC = -mn * C;
  for (int r = 0; r < 16; ++r) p0[r] = fmaf(p0[r], C, mnC); for (int r = 0; r < 16; ++r) p1[r] = fmaf(p1[r], C, mnC);
  for (int r = 0; r < 16; ++r) p0[r] = __builtin_amdgcn_exp2f(p0[r]);
}
__device__ __forceinline__ void finishSM(f32x16& p0, f32x16& p1, float alpha, float& l_reg, bf16x8& pa0, bf16x8& pa1, bf16x8& pa2, bf16x8& pa3) {
  for (int r = 0; r < 16; ++r) p1[r] = __builtin_amdgcn_exp2f(p1[r]);
  float ps = 0; for (int r = 0; r < 16; ++r) ps += p0[r]; for (int r = 0; r < 16; ++r) ps += p1[r];
  { auto rr = __builtin_amdgcn_permlane32_swap(__float_as_uint(ps), __float_as_uint(ps), false, false);
    ps = __uint_as_float(rr[0]) + __uint_as_float(rr[1]); }
  l_reg = l_reg * alpha + ps;
#define PK4(P, BASE, OUT) do { unsigned a0 = cvtpk_asm(P[BASE + 0], P[BASE + 1]), a1 = cvtpk_asm(P[BASE + 2], P[BASE + 3]);   \
    unsigned b0 = cvtpk_asm(P[BASE + 4], P[BASE + 5]), b1 = cvtpk_asm(P[BASE + 6], P[BASE + 7]);                              \
    auto r0 = __builtin_amdgcn_permlane32_swap(a0, b0, false, false); auto r1 = __builtin_amdgcn_permlane32_swap(a1, b1, false, false); \
    u32x4 w = {r0[0], r1[0], r0[1], r1[1]}; OUT = *reinterpret_cast<bf16x8*>(&w); } while (0)
  PK4(p0, 0, pa0); PK4(p0, 8, pa1); PK4(p1, 0, pa2); PK4(p1, 8, pa3);
#undef PK4
}
__device__ __forceinline__ void qkt(f32x16& p0, f32x16& p1, const bf16_t* Ks, const bf16x8* qr, int r32, int hi) {
  p0 = f32x16{}; p1 = f32x16{};
  for (int d0 = 0; d0 < 8; ++d0) { int cb = (d0 * 16 + hi * 8) * 2;
    bf16x8 b0 = *reinterpret_cast<const bf16x8*>((const char*)Ks + KSWZ(r32, cb));
    bf16x8 b1 = *reinterpret_cast<const bf16x8*>((const char*)Ks + KSWZ(32 + r32, cb));
    p0 = __builtin_amdgcn_mfma_f32_32x32x16_bf16(b0, qr[d0], p0, 0, 0, 0);
    p1 = __builtin_amdgcn_mfma_f32_32x32x16_bf16(b1, qr[d0], p1, 0, 0, 0); }
}
__device__ __forceinline__ int v_st(int k, int c) { const int kk = (k & ~0xC) | ((k & 4) << 1) | ((k & 8) >> 1); return ((kk >> 3) * 4 + (c >> 5)) * 512 + ((kk & 7) * 32 + (c & 31)) * 2; }
__device__ __forceinline__ int v_rd_base(int lane) { return ((lane & 3) << 3) | (((lane >> 2) & 3) << 6) | (((lane >> 4) & 1) << 5) | (((lane >> 5) & 1) << 8); }
constexpr int v_rd_off(int d0, int ks, int half) { return d0 * 512 + ks * 4096 + half * 2048; }
template <int OFF> __device__ __forceinline__ s16x4 tr_read(int vb) {
  s16x4 r; asm volatile("ds_read_b64_tr_b16 %0, %1 offset:%2" : "=&v"(r) : "v"(vb), "i"(OFF) : "memory"); return r;
}
template <int D0> __device__ __forceinline__ void pv_one(f32x16& od, int vb, bf16x8 pa0, bf16x8 pa1, bf16x8 pa2, bf16x8 pa3) {
  const s16x4 l0 = tr_read<v_rd_off(D0, 0, 0)>(vb), h0 = tr_read<v_rd_off(D0, 0, 1)>(vb), l1 = tr_read<v_rd_off(D0, 1, 0)>(vb), h1 = tr_read<v_rd_off(D0, 1, 1)>(vb);
  const s16x4 l2 = tr_read<v_rd_off(D0, 2, 0)>(vb), h2 = tr_read<v_rd_off(D0, 2, 1)>(vb), l3 = tr_read<v_rd_off(D0, 3, 0)>(vb), h3 = tr_read<v_rd_off(D0, 3, 1)>(vb);
  asm volatile("s_waitcnt lgkmcnt(0)" ::: "memory"); SBAR();
#define PK(L, H) (bf16x8){L[0], L[1], L[2], L[3], H[0], H[1], H[2], H[3]}
  od = __builtin_amdgcn_mfma_f32_32x32x16_bf16(pa0, PK(l0, h0), od, 0, 0, 0);
  od = __builtin_amdgcn_mfma_f32_32x32x16_bf16(pa1, PK(l1, h1), od, 0, 0, 0);
  od = __builtin_amdgcn_mfma_f32_32x32x16_bf16(pa2, PK(l2, h2), od, 0, 0, 0);
  od = __builtin_amdgcn_mfma_f32_32x32x16_bf16(pa3, PK(l3, h3), od, 0, 0, 0);
#undef PK
}
__device__ __forceinline__ void pv_d0(f32x16* o, int vb, bf16x8 pa0, bf16x8 pa1, bf16x8 pa2, bf16x8 pa3) {
  pv_one<0>(o[0], vb, pa0, pa1, pa2, pa3); pv_one<1>(o[1], vb, pa0, pa1, pa2, pa3); pv_one<2>(o[2], vb, pa0, pa1, pa2, pa3); pv_one<3>(o[3], vb, pa0, pa1, pa2, pa3);
}
__device__ __forceinline__ void attn_dense_body(const bf16_t* __restrict__ Qb, const bf16_t* __restrict__ Kh, const bf16_t* __restrict__ Vh,
                                                bf16_t* __restrict__ Ob, int seq, char* lds, int wv) {
  const int tid = otid(wv), wid = wv, lane = tid & 63, r32 = lane & 31, hi = lane >> 5;
  bf16_t* V_lds = (bf16_t*)lds; bf16_t* K_lds = (bf16_t*)(lds + 2 * SHM_V);
  float* ws = (float*)(lds + 2 * SHM_V + 2 * SHM_K) + wid * 64; float* li_l = ws; float* al_l = ws + 32;
  float m_reg = -1e30f, l_reg = 0; f32x16 o[4] = {}; bf16x8 qr[8];
  const bf16_t* Qw = Qb + (long)(wid * QBLK + r32) * LDQ + hi * 8;
#pragma unroll
  for (int d0 = 0; d0 < 8; ++d0) qr[d0] = *reinterpret_cast<const bf16x8*>(Qw + d0 * 16);
  const int sr = tid >> 4, sc = (tid & 15) * 8, vst0 = v_st(sr, sc), vst1 = v_st(32 + sr, sc);
  const int vb0 = (int)(uintptr_t)V_lds + v_rd_base(lane);
  struct { bf16x8 vs0, vs1, ks0, ks1; } sr_[2];
#define SLOAD(i, k0) do { sr_[i].vs0 = *reinterpret_cast<const bf16x8*>(&Vh[(long)((k0) + sr) * LDK + sc]); sr_[i].vs1 = *reinterpret_cast<const bf16x8*>(&Vh[(long)((k0) + 32 + sr) * LDK + sc]); \
    sr_[i].ks0 = *reinterpret_cast<const bf16x8*>(&Kh[(long)((k0) + sr) * LDK + sc]); sr_[i].ks1 = *reinterpret_cast<const bf16x8*>(&Kh[(long)((k0) + 32 + sr) * LDK + sc]); } while (0)
#define SWRITE(b, i) do { *(bf16x8*)((char*)V_lds + (b) * SHM_V + vst0) = sr_[i].vs0;          \
    *(bf16x8*)((char*)V_lds + (b) * SHM_V + vst1) = sr_[i].vs1; int kc = sc * 2;               \
    *(bf16x8*)((char*)K_lds + (b) * SHM_K + KSWZ(sr, kc)) = sr_[i].ks0;                       \
    *(bf16x8*)((char*)K_lds + (b) * SHM_K + KSWZ(32 + sr, kc)) = sr_[i].ks1; } while (0)
#define SWAIT() asm volatile("s_waitcnt vmcnt(4)" ::: "memory")
#define RESC(a) do { if (__any((a) < 1.f)) { if (hi == 0) al_l[r32] = (a); asm volatile("s_waitcnt lgkmcnt(0)" ::: "memory"); \
    for (int d = 0; d < 4; ++d) for (int r = 0; r < 16; ++r) o[d][r] *= al_l[crow(r, hi)]; } } while (0)
  f32x16 pA0, pA1, pB0, pB1; float mnA, mnB, alA, alB; bf16x8 pa0, pa1, pa2, pa3; const int NT = seq / KVBLK;
  constexpr int SE = 0, SO = 1;
  SLOAD(SE, 0); asm volatile("s_waitcnt vmcnt(0)" ::: "memory"); SWRITE(0, SE); __syncthreads();
  qkt(pA0, pA1, K_lds, qr, r32, hi); partialSM(pA0, pA1, m_reg, mnA, alA);
  SLOAD(SO, KVBLK); if (2 < NT) SLOAD(SE, 2 * KVBLK);
  SWAIT(); SWRITE(1, SO); __syncthreads();
  for (int j = 1; j + 1 < NT; j += 2) {
    SBAR(); qkt(pB0, pB1, (bf16_t*)((char*)K_lds + SHM_K), qr, r32, hi);
    finishSM(pA0, pA1, alA, l_reg, pa0, pa1, pa2, pa3); SBAR();
    SLOAD(SO, (j + 2) * KVBLK); SBAR();
    pv_d0(o, vb0, pa0, pa1, pa2, pa3); partialSM(pB0, pB1, m_reg, mnB, alB);
    __syncthreads(); SWAIT(); SWRITE(0, SE);
    RESC(alB); __syncthreads();
    SBAR(); qkt(pA0, pA1, K_lds, qr, r32, hi);
    finishSM(pB0, pB1, alB, l_reg, pa0, pa1, pa2, pa3); SBAR();
    if (j + 3 < NT) SLOAD(SE, (j + 3) * KVBLK); SBAR();
    pv_d0(o, vb0 + (int)SHM_V, pa0, pa1, pa2, pa3); partialSM(pA0, pA1, m_reg, mnA, alA);
    __syncthreads(); SWAIT(); SWRITE(1, SO);
    RESC(alA); __syncthreads();
  }
  SBAR(); qkt(pB0, pB1, (bf16_t*)((char*)K_lds + SHM_K), qr, r32, hi);
  finishSM(pA0, pA1, alA, l_reg, pa0, pa1, pa2, pa3); SBAR();
  pv_d0(o, vb0, pa0, pa1, pa2, pa3); partialSM(pB0, pB1, m_reg, mnB, alB);
  __syncthreads(); RESC(alB);
  finishSM(pB0, pB1, alB, l_reg, pa0, pa1, pa2, pa3); SBAR();
  pv_d0(o, vb0 + (int)SHM_V, pa0, pa1, pa2, pa3);
  if (hi == 0) li_l[r32] = l_reg; asm volatile("s_waitcnt lgkmcnt(0)" ::: "memory");
  float rli[16];
#pragma unroll
  for (int r = 0; r < 16; ++r) rli[r] = __builtin_amdgcn_rcpf(li_l[crow(r, hi)]);
  bf16_t* Ow = Ob + (long)(wid * QBLK) * LDO;
#pragma unroll
  for (int r = 0; r < 16; ++r) { int orow = crow(r, hi);
#pragma unroll
    for (int d0 = 0; d0 < 4; ++d0) Ow[(long)orow * LDO + d0 * 32 + r32] = f2bf(o[d0][r] * rli[r]); }
#undef SLOAD
#undef SWRITE
#undef SWAIT
#undef RESC
}
}

__device__ __forceinline__ void prep_phase(KP p, int wv, int l, char* lds) {
  p = relaunder(p);
  const int tid = otid(wv), wid = tid >> 6, lane = tid & 63;
  const float qg1 = p->q_norm_g[l * 128 + lane], qg2 = p->q_norm_g[l * 128 + 64 + lane];
  const float kg1 = p->k_norm_g[l * 128 + lane], kg2 = p->k_norm_g[l * 128 + 64 + lane];
  const float invf = powf(10000.f, -(float)(lane & 31) / 32.f);
  for (int row = blockIdx.x * 8 + wid; row < NROWS; row += gridDim.x * 8) {
    const int rb = row % RPB; const bool lat = rb >= CTX; const int t = rb - CTX;
    float cs = 1.f, sn = 0.f;
    if (lat) { const float pos = (lane < 32) ? (float)(t >> 6) : (float)(t & 63); const float ang = pos * invf; sincosf(ang, &sn, &cs); }
    bf16_t* zr = p->Z + (size_t)row * ZLD;
    bf16_t r1[18], r2[18];
#pragma unroll
    for (int hs = 0; hs < 18; ++hs) {
      const int col0 = hs < 8 ? C_AQ + hs * 128 : hs < 10 ? C_AK + (hs - 8) * 128 : hs < 14 ? C_RQ + (hs - 10) * 128 : C_RK + (hs - 14) * 128;
      r1[hs] = zr[col0 + lane]; r2[hs] = zr[col0 + 64 + lane];
    }
    const u32x2 vcopy = *(const u32x2*)(zr + C_AV + (lane >> 5) * 128 + (lane & 31) * 4);
#pragma unroll
    for (int hs = 0; hs < 18; ++hs) {
      const int col0 = hs < 8 ? C_AQ + hs * 128 : hs < 10 ? C_AK + (hs - 8) * 128 : hs < 14 ? C_RQ + (hs - 10) * 128 : C_RK + (hs - 14) * 128;
      float x1 = bf2f(r1[hs]), x2 = bf2f(r2[hs]);
      if (hs < 10) {
        const float ss = wave_sum(x1 * x1 + x2 * x2);
        const float r = rsqrtf(ss * (1.f / 128.f) + EPS);
        x1 = x1 * r * (hs < 8 ? qg1 : kg1); x2 = x2 * r * (hs < 8 ? qg2 : kg2);
      }
      if (hs >= 14) { x1 *= 0.088388347648318440f; x2 *= 0.088388347648318440f; }
      const float o1 = x1 * cs - x2 * sn, o2 = x1 * sn + x2 * cs;
      if (hs == 8 || hs == 9) { bf16_t* kc = p->Kc + ((size_t)((row / RPB) * 2 + (hs - 8)) * RPB + rb) * 128; kc[lane] = f2bf(o1); kc[64 + lane] = f2bf(o2); }
      else { zr[col0 + lane] = f2bf(o1); zr[col0 + 64 + lane] = f2bf(o2); }
    }
    { const int kvh = lane >> 5, d4 = (lane & 31) * 4;
      *(u32x2*)(p->Vc + ((size_t)((row / RPB) * 2 + kvh) * RPB + rb) * 128 + d4) = vcopy; }
  }
  {
    const int dir = tid >> 8, col = tid & 255;
    float up[16];
#pragma unroll
    for (int r = 0; r < 16; ++r) up[r] = p->gla_gate_up[((size_t)(l * 2 + dir) * 16 + r) * 256 + col];
    const float bias = p->gla_gate_b[(l * 2 + dir) * 256 + col];
    for (int ch = (int)gridDim.x - 1 - (int)blockIdx.x; ch < NROWS / 64; ch += gridDim.x) {
      float bacc = 0.f;
#pragma unroll 1
      for (int s0 = 0; s0 < 64; s0 += 8) {
        bf16x8 g0[8], g1[8]; bf16_t qv[8], kv[8];
#pragma unroll
        for (int j = 0; j < 8; ++j) {
          const int row = ch * 64 + (dir ? 63 - (s0 + j) : (s0 + j));
          const bf16_t* zr = p->Z + (size_t)row * ZLD;
          g0[j] = *(const bf16x8*)(zr + C_GA + dir * 16); g1[j] = *(const bf16x8*)(zr + C_GA + dir * 16 + 8);
          qv[j] = zr[C_GQ + col]; kv[j] = zr[C_GK + col];
        }
#pragma unroll
        for (int j = 0; j < 8; ++j) {
          const int row = ch * 64 + (dir ? 63 - (s0 + j) : (s0 + j));
          float logit = bias;
#pragma unroll
          for (int r = 0; r < 8; ++r) logit += bf2f((bf16_t)g0[j][r]) * up[r] + bf2f((bf16_t)g1[j][r]) * up[8 + r];
          const float ls = fminf(logit, 0.f) - 0.6931471805599453f * __builtin_amdgcn_logf(1.f + fexp(-fabsf(logit)));
          bacc += ls * (1.f / 16.f);
          const size_t o = ((size_t)dir * NROWS + row) * 256 + col;
          p->GQt[o] = f2bf(bf2f(qv[j]) * 0.125f * fexp(bacc));
          p->GKt[o] = f2bf(bf2f(kv[j]) * fexp(-bacc));
        }
      }
      p->Eend[((size_t)dir * (NROWS / 64) + ch) * 256 + col] = fexp(bacc);
    }
  }
  for (int u = blockIdx.x; u < 2 * DFF / 32; u += gridDim.x) gemv9_unit<1>(p, wv, u, l, lds);
  if (l == 0) for (int u = (int)gridDim.x - 1 - (int)blockIdx.x; u < ZLD / 32; u += gridDim.x) gemv9_unit<2>(p, wv, u, 1, lds);
}

__device__ __forceinline__ int scan_row(int b, int s, int dir) { return b * RPB + (dir == 0 ? s : (s < CTX ? CTX - 1 - s : RPB + CTX - 1 - s)); }

#define MFMA16(a, b, c) __builtin_amdgcn_mfma_f32_16x16x32_bf16(a, b, c, 0, 0, 0)
__device__ __forceinline__ bf16x8 pack8(u32x2 lo, u32x2 hi) { u32x4 w = {lo[0], lo[1], hi[0], hi[1]}; return *reinterpret_cast<bf16x8*>(&w); }

__device__ __forceinline__ void ret_scan_unit(KP p, int wv, int l, int u, bool last, char* lds) {
  p = relaunder(p);
  constexpr int ST = 272, IMG = 128 * ST;
  char* Qs = lds; char* Ks = lds + IMG; char* KTs = lds + 2 * IMG; char* VTs = lds + 3 * IMG;
  const int tid = otid(wv), wid = wv, lane = tid & 63, fr = lane & 15, fq = lane >> 4;
  const int b = u >> 3, h = (u >> 1) & 3, dir = u & 1;
  const float lg2 = p->ret_log_decay[l * 8 + dir * 4 + h] * 1.4426950408889634f;
  const float cdec = __builtin_amdgcn_exp2f(lg2 * 128.f);
  const int sr = tid >> 2, sc = (tid & 3) * 32;
  const float vsc = __builtin_amdgcn_exp2f(lg2 * (float)(127 - sr));
  bf16x8 rq[4], rk[4], rv[4];
#define RLOAD(c) do { const bf16_t* base_ = p->Z + (size_t)scan_row(b, (c) * 128 + sr, dir) * ZLD + h * 128 + sc; \
    _Pragma("unroll") for (int k = 0; k < 4; ++k) { rq[k] = *(const bf16x8*)(base_ + C_RQ + k * 8); rk[k] = *(const bf16x8*)(base_ + C_RK + k * 8); rv[k] = *(const bf16x8*)(base_ + C_RV + k * 8); } } while (0)
  f32x4 S[8];
#pragma unroll
  for (int i = 0; i < 8; ++i) S[i] = (f32x4){0.f, 0.f, 0.f, 0.f};
  RLOAD(0);
#pragma unroll 1
  for (int c = 0; c < 18; ++c) {
#pragma unroll
    for (int k = 0; k < 4; ++k) {
      *(bf16x8*)(Qs + sr * ST + (sc + k * 8) * 2) = rq[k];
      *(bf16x8*)(Ks + sr * ST + (sc + k * 8) * 2) = rk[k];
#pragma unroll
      for (int e = 0; e < 8; ++e) {
        const int d = sc + k * 8 + e;
        *(bf16_t*)(KTs + d * ST + sr * 2) = (bf16_t)rk[k][e];
        *(bf16_t*)(VTs + d * ST + sr * 2) = f2bf(bf2f((bf16_t)rv[k][e]) * vsc);
      }
    }
    if (c + 1 < 18) RLOAD(c + 1);
    __syncthreads();
    bf16x8 vf[4];
#pragma unroll
    for (int ks = 0; ks < 4; ++ks) vf[ks] = *(const bf16x8*)(VTs + (16 * wid + fr) * ST + (ks * 32 + fq * 8) * 2);
    const bool need_out = !(last && c < 2);
    if (need_out) {
      bf16x8 qf[4];
#pragma unroll
      for (int ks = 0; ks < 4; ++ks) qf[ks] = *(const bf16x8*)(Qs + (16 * wid + fr) * ST + (ks * 32 + fq * 8) * 2);
      u32x2 pt[8];
#pragma unroll
      for (int jt = 0; jt < 8; ++jt) {
        pt[jt] = (u32x2){0u, 0u};
        if (jt <= wid) {
          f32x4 a = {0.f, 0.f, 0.f, 0.f};
#pragma unroll
          for (int ks = 0; ks < 4; ++ks) { const bf16x8 kf = *(const bf16x8*)(Ks + (16 * jt + fr) * ST + (ks * 32 + fq * 8) * 2); a = MFMA16(kf, qf[ks], a); }
          if (jt == wid) {
#pragma unroll
            for (int jj = 0; jj < 4; ++jj) if (4 * fq + jj > fr) a[jj] = 0.f;
          }
          pt[jt][0] = cvtpk(a[0], a[1]); pt[jt][1] = cvtpk(a[2], a[3]);
        }
      }
      __syncthreads();
#pragma unroll
      for (int jt = 0; jt < 8; ++jt)
        if (jt <= wid || (jt == wid + 1 && !(wid & 1))) *(u32x2*)(Ks + (16 * wid + fr) * ST + (16 * jt + 4 * fq) * 2) = pt[jt];
      __syncthreads();
      bf16x8 sop[4];
#pragma unroll
      for (int s = 0; s < 4; ++s) { u32x4 w = {cvtpk(S[2 * s][0], S[2 * s][1]), cvtpk(S[2 * s][2], S[2 * s][3]), cvtpk(S[2 * s + 1][0], S[2 * s + 1][1]), cvtpk(S[2 * s + 1][2], S[2 * s + 1][3])}; sop[s] = *reinterpret_cast<bf16x8*>(&w); }
#pragma unroll
      for (int it = 0; it < 8; ++it) {
        f32x4 aO = {0.f, 0.f, 0.f, 0.f}, aT = {0.f, 0.f, 0.f, 0.f};
#pragma unroll
        for (int ks = 0; ks < 4; ++ks) if (ks <= (it >> 1)) { const bf16x8 pf = *(const bf16x8*)(Ks + (16 * it + fr) * ST + (ks * 32 + fq * 8) * 2); aO = MFMA16(vf[ks], pf, aO); }
#pragma unroll
        for (int s = 0; s < 4; ++s) {
          const u32x2 lo = *(const u32x2*)(Qs + (16 * it + fr) * ST + (32 * s + 4 * fq) * 2), hi = *(const u32x2*)(Qs + (16 * it + fr) * ST + (32 * s + 16 + 4 * fq) * 2);
          aT = MFMA16(sop[s], pack8(lo, hi), aT);
        }
        const int i = 16 * it + fr;
        const float sP = __builtin_amdgcn_exp2f(lg2 * (float)(i - 127)), sS = __builtin_amdgcn_exp2f(lg2 * (float)(i + 1));
        { const f32x4 o = aO * sP + aT * sS; u32x2 w; w[0] = cvtpk(o[0], o[1]); w[1] = cvtpk(o[2], o[3]);
          *(u32x2*)(p->RO + ((size_t)dir * NROWS + scan_row(b, c * 128 + i, dir)) * 512 + h * 128 + 16 * wid + 4 * fq) = w; }
      }
    }
#pragma unroll
    for (int td = 0; td < 8; ++td) {
      f32x4 a = S[td] * cdec;
#pragma unroll
      for (int ks = 0; ks < 4; ++ks) { const bf16x8 ktf = *(const bf16x8*)(KTs + (16 * td + fr) * ST + (ks * 32 + fq * 8) * 2); a = MFMA16(ktf, vf[ks], a); }
      S[td] = a;
    }
    __syncthreads();
  }
#undef RLOAD
}

__device__ __forceinline__ void gla_scan_unit(KP p, int wv, int l, int u, bool last, char* lds) {
  p = relaunder(p);
  constexpr int ST = 144;
  char* Qs = lds; char* Ks = lds + 64 * ST; char* KTs = lds + 128 * ST; char* VTs = lds + 192 * ST;
  const int tid = otid(wv), wid = wv, lane = tid & 63, fr = lane & 15, fq = lane >> 4;
  const int b = u >> 3, h = (u >> 1) & 3, dir = u & 1;
  const int sr = tid >> 3, sc8 = (tid & 7) * 8, sc16 = (tid & 7) * 16;
  bf16x8 rq, rk, rv[2];
#define GLOAD(c) do { const int row_ = scan_row(b, (c) * 64 + sr, dir); const size_t o_ = ((size_t)dir * NROWS + row_) * 256 + h * 64 + sc8; \
    rq = *(const bf16x8*)(p->GQt + o_); rk = *(const bf16x8*)(p->GKt + o_); const bf16_t* vb_ = p->Z + (size_t)row_ * ZLD + C_GV + h * 128 + sc16; \
    rv[0] = *(const bf16x8*)(vb_); rv[1] = *(const bf16x8*)(vb_ + 8); } while (0)
  f32x4 S[4];
#pragma unroll
  for (int i = 0; i < 4; ++i) S[i] = (f32x4){0.f, 0.f, 0.f, 0.f};
  GLOAD(0);
#pragma unroll 1
  for (int c = 0; c < 36; ++c) {
    *(bf16x8*)(Qs + sr * ST + sc8 * 2) = rq;
    *(bf16x8*)(Ks + sr * ST + sc8 * 2) = rk;
#pragma unroll
    for (int e = 0; e < 8; ++e) *(bf16_t*)(KTs + (sc8 + e) * ST + sr * 2) = (bf16_t)rk[e];
#pragma unroll
    for (int k = 0; k < 2; ++k)
#pragma unroll
      for (int e = 0; e < 8; ++e) *(bf16_t*)(VTs + (sc16 + k * 8 + e) * ST + sr * 2) = (bf16_t)rv[k][e];
    const int chid = scan_row(b, c * 64 + (dir ? 63 : 0), dir) >> 6;
    f32x4 ee[4];
#pragma unroll
    for (int td = 0; td < 4; ++td) ee[td] = *(const f32x4*)(p->Eend + ((size_t)dir * (NROWS / 64) + chid) * 256 + h * 64 + 16 * td + 4 * fq);
    if (c + 1 < 36) GLOAD(c + 1);
    __syncthreads();
    bf16x8 vf[2];
#pragma unroll
    for (int ks = 0; ks < 2; ++ks) vf[ks] = *(const bf16x8*)(VTs + (16 * wid + fr) * ST + (ks * 32 + fq * 8) * 2);
    const bool need_out = !(last && c < 4);
    if (need_out) {
      const int it = wid >> 1, jt0 = (wid & 1) * 2;
      bf16x8 qf[2];
#pragma unroll
      for (int ks = 0; ks < 2; ++ks) qf[ks] = *(const bf16x8*)(Qs + (16 * it + fr) * ST + (ks * 32 + fq * 8) * 2);
      u32x2 pt[2];
#pragma unroll
      for (int t = 0; t < 2; ++t) {
        const int jt = jt0 + t;
        pt[t] = (u32x2){0u, 0u};
        if (jt <= it) {
          f32x4 a = {0.f, 0.f, 0.f, 0.f};
#pragma unroll
          for (int ks = 0; ks < 2; ++ks) { const bf16x8 kf = *(const bf16x8*)(Ks + (16 * jt + fr) * ST + (ks * 32 + fq * 8) * 2); a = MFMA16(kf, qf[ks], a); }
          if (jt == it) {
#pragma unroll
            for (int jj = 0; jj < 4; ++jj) if (4 * fq + jj > fr) a[jj] = 0.f;
          }
          pt[t][0] = cvtpk(a[0], a[1]); pt[t][1] = cvtpk(a[2], a[3]);
        }
      }
      __syncthreads();
#pragma unroll
      for (int t = 0; t < 2; ++t) *(u32x2*)(Ks + (16 * it + fr) * ST + (16 * (jt0 + t) + 4 * fq) * 2) = pt[t];
      __syncthreads();
      bf16x8 sop[2];
#pragma unroll
      for (int s = 0; s < 2; ++s) { u32x4 w = {cvtpk(S[2 * s][0], S[2 * s][1]), cvtpk(S[2 * s][2], S[2 * s][3]), cvtpk(S[2 * s + 1][0], S[2 * s + 1][1]), cvtpk(S[2 * s + 1][2], S[2 * s + 1][3])}; sop[s] = *reinterpret_cast<bf16x8*>(&w); }
#pragma unroll
      for (int i2 = 0; i2 < 4; ++i2) {
        f32x4 a = {0.f, 0.f, 0.f, 0.f};
#pragma unroll
        for (int ks = 0; ks < 2; ++ks) if (ks <= (i2 >> 1)) { const bf16x8 pf = *(const bf16x8*)(Ks + (16 * i2 + fr) * ST + (ks * 32 + fq * 8) * 2); a = MFMA16(vf[ks], pf, a); }
#pragma unroll
        for (int s = 0; s < 2; ++s) {
          const u32x2 lo = *(const u32x2*)(Qs + (16 * i2 + fr) * ST + (32 * s + 4 * fq) * 2), hi = *(const u32x2*)(Qs + (16 * i2 + fr) * ST + (32 * s + 16 + 4 * fq) * 2);
          a = MFMA16(sop[s], pack8(lo, hi), a);
        }
        { u32x2 w; w[0] = cvtpk(a[0], a[1]); w[1] = cvtpk(a[2], a[3]);
          *(u32x2*)(p->GO + ((size_t)dir * NROWS + scan_row(b, c * 64 + 16 * i2 + fr, dir)) * 512 + h * 128 + 16 * wid + 4 * fq) = w; }
      }
    }
#pragma unroll
    for (int td = 0; td < 4; ++td) {
      f32x4 a = S[td];
#pragma unroll
      for (int ks = 0; ks < 2; ++ks) { const bf16x8 ktf = *(const bf16x8*)(KTs + (16 * td + fr) * ST + (ks * 32 + fq * 8) * 2); a = MFMA16(ktf, vf[ks], a); }
      S[td] = a * ee[td];
    }
    __syncthreads();
  }
#undef GLOAD
}

__device__ __forceinline__ void attn_unit(KP p, int wv, int a, char* lds) {
  p = relaunder(p);
  int b, h, kvh, qrow0, seq;
  if (a < 512) { const int x = a & 7, j = (a >> 3) & 31, rnd = a >> 8; b = rnd * 4 + (x >> 1); kvh = x & 1; h = kvh * 4 + (j >> 3); qrow0 = b * RPB + CTX + (j & 7) * 256; seq = RPB; }
  else { const int c = a - 512; b = c >> 3; h = c & 7; kvh = h >> 2; qrow0 = b * RPB; seq = CTX; }
  const bf16_t* Q = p->Z + (size_t)qrow0 * ZLD + C_AQ + h * 128;
  const bf16_t* Kp = p->Kc + (size_t)(b * 2 + kvh) * RPB * 128;
  const bf16_t* Vp = p->Vc + (size_t)(b * 2 + kvh) * RPB * 128;
  at::attn_dense_body(Q, Kp, Vp, p->H + (size_t)qrow0 * DM + h * 128, seq, lds, wv);
  __syncthreads();
}
__device__ __forceinline__ void mix1_phase(KP p, int wv, int l, bool last, char* lds, volatile LAS unsigned* bc) {
  p = relaunder(p);
  const int i = blockIdx.x;
  {
  if (i < 64) ret_scan_unit(p, wv, l, i, last, lds); else if (i < 128) gla_scan_unit(p, wv, l, i - 64, last, lds);
  }
  for (int u = i + 128; u < 128; u += gridDim.x) { if (u < 64) ret_scan_unit(p, wv, l, u, last, lds); else gla_scan_unit(p, wv, l, u - 64, last, lds); }
  const int q = i & 7, nq = last ? 64 : 72;
  for (;;) {
    unsigned* head = p->ctl + WQ_WORD(l, q); asm volatile("" : "+s"(head));
    volatile LAS unsigned* bcl = bc; asm volatile("" : "+s"(bcl));
    __syncthreads();
    if (otid(wv) == 0) bcl[2] = xb_add(head, 1u);
    __syncthreads();
    const int k = __builtin_amdgcn_readfirstlane((int)bcl[2]);
    if (k >= nq) break;
    attn_unit(p, wv, q + 8 * k, lds);
  }
}

__device__ __forceinline__ void mix2_phase(KP p, int wv, int l, bool last) {
  p = relaunder(p);
  const int tid_ = otid(wv); const int wid = wv, lane = tid_ & 63;
  const float rg1 = p->ret_norm_g[l * 128 + lane], rg2 = p->ret_norm_g[l * 128 + 64 + lane];
  const float gg1 = p->gla_norm_g[l * 128 + lane], gg2 = p->gla_norm_g[l * 128 + 64 + lane];
  for (int row = blockIdx.x * 8 + wid; row < NROWS; row += gridDim.x * 8) {
    if (last && (row % RPB) < CTX) continue;
    float x1[8], x2[8], g1[8], g2[8];
#pragma unroll
    for (int slot = 0; slot < 8; ++slot) {
      const bool isg = slot >= 4; const int h = slot & 3;
      const bf16_t* O = isg ? p->GO : p->RO;
      const size_t o0 = (size_t)row * 512 + h * 128, o1 = ((size_t)NROWS + row) * 512 + h * 128;
      x1[slot] = bf2f(__builtin_nontemporal_load(O + o0 + lane)) + bf2f(__builtin_nontemporal_load(O + o1 + lane)); x2[slot] = bf2f(__builtin_nontemporal_load(O + o0 + 64 + lane)) + bf2f(__builtin_nontemporal_load(O + o1 + 64 + lane));
      const bf16_t* zg = p->Z + (size_t)row * ZLD + (isg ? C_GR : C_RG) + h * 128;
      g1[slot] = bf2f(zg[lane]); g2[slot] = bf2f(zg[64 + lane]);
    }
#pragma unroll
    for (int slot = 0; slot < 8; ++slot) {
      const bool isg = slot >= 4;
      const float ss = wave_sum(x1[slot] * x1[slot] + x2[slot] * x2[slot]);
      const float r = rsqrtf(ss * (1.f / 128.f) + EPS);
      bf16_t* hp = p->H + (size_t)row * DM + 1024 + slot * 128;
      hp[lane] = f2bf(x1[slot] * r * (isg ? gg1 : rg1) * silu_f(g1[slot]));
      hp[64 + lane] = f2bf(x2[slot] * r * (isg ? gg2 : rg2) * silu_f(g2[slot]));
    }
  }
}

__device__ __forceinline__ void fixup_phase(KP p, int wv, int l, bool last) {
  p = relaunder(p);
  const float* cw = p->conv_w + (size_t)l * 3 * DFF;
  const int total = 72 * 2 * DFF;
  const int tid_ = otid(wv);
  for (int i = blockIdx.x * NTHR + tid_; i < total; i += gridDim.x * NTHR) {
    const int f = i % DFF, pe = i / DFF, pm = pe >> 1, e = pe & 1, k = pm % 9;
    if (k == 0) continue;
    if (e == 0 && k == 1) continue;
    if (e == 1 && k == 8) continue;
    const float* hb = p->HB + (((size_t)(pm * 2 + e)) * DFF + f) * 2;
    const float part = hb[0], v = hb[1];
    float cvv; int row;
    if (e == 0) { const float an = p->HA[((size_t)((pm - 1) * 2 + 1)) * DFF + f]; cvv = part + an * cw[f]; row = pm * 256; }
    else { const float an = p->HA[((size_t)((pm + 1) * 2 + 0)) * DFF + f]; cvv = part + an * cw[2 * DFF + f]; row = pm * 256 + 255; }
    p->U[(size_t)row * DFF + f] = f2bf(silu_f(cvv) * v);
  }
}

__device__ __forceinline__ void final_phase(KP p, int wv) {
  p = relaunder(p);
  const int tid_ = otid(wv); const int wid = wv, lane = tid_ & 63;
  for (int r0 = (blockIdx.x * 8 + wid) * 2; r0 < NB * SEQ; r0 += gridDim.x * 16) {
    f32x4 v[2][8];
#pragma unroll
    for (int q = 0; q < 2; ++q) { const int rr = r0 + q, b = rr / SEQ, t = rr % SEQ; const float* xr = p->X + (size_t)(b * RPB + CTX + t) * DM;
#pragma unroll
      for (int i = 0; i < 8; ++i) v[q][i] = *(const f32x4*)(xr + i * 256 + lane * 4); }
#pragma unroll
    for (int q = 0; q < 2; ++q) {
      float ss = 0.f;
#pragma unroll
      for (int i = 0; i < 8; ++i) ss += v[q][i][0] * v[q][i][0] + v[q][i][1] * v[q][i][1] + v[q][i][2] * v[q][i][2] + v[q][i][3] * v[q][i][3];
      ss = wave_sum(ss);
      const float r = rsqrtf(ss * (1.f / DM) + EPS);
#pragma unroll
      for (int i = 0; i < 8; ++i) { const int col = i * 256 + lane * 4; const f32x4 gg = *(const f32x4*)(p->final_norm_g + col);
        __builtin_nontemporal_store(v[q][i] * r * gg, (f32x4*)(p->out + (size_t)(r0 + q) * DM + col)); }
    }
  }
}

#define GSYNC() xcd_barrier(xbar)
template <int l>
__device__ __forceinline__ void layer_body(KP p, int wv, char* shm, cg::grid_group& grid, const XcdBarrier& xbar, volatile LAS unsigned* bcw) {
  constexpr bool last = (l == 1);
  const int G = gridDim.x;

    if (l == 0) {
      for (int u = blockIdx.x; u < 768; u += G) gemv9_unit<0>(p, wv, u, 0, shm);
      conv_phase(p, wv, 0, shm, 0, CV_IN + CV_OUT, 0);
      if (p->out == nullptr) grid.sync();
      GSYNC();
      norm_phase(p, wv, 0, 0, true, false);
      GSYNC();
    }
    for (int i = blockIdx.x; i < 72 * 21; i += G) { int pm, pn, qm = -1, qn = -1; tile_map(i, 72, 21, pm, pn, 4); if (i + G < 72 * 21) tile_map(i + G, 72, 21, qm, qn, 4);
      const bool pre = i != (int)blockIdx.x; const int nr = qm < 0 ? -1 : qm * 256, nc = qn * 256;
      if (l == 0) { EpiBf16<false> epi{p->Z, ZLD, nullptr, nullptr}; gemm_tile(p->H, DM, p->Wt_in, DM, DM, pm * 256, pn * 256, shm, epi, wv, pre, nr, nc); }
      else { EpiBf16<true> epi{p->Z, ZLD, (const float*)(p->ctl + SSQ_WORD) + (size_t)2 * NROWS, p->sWin + (size_t)((pm % 9) == 0 ? 8 : pm / 9) * ZLD}; gemm_tile(p->H, DM, p->Wt_in, DM, DM, pm * 256, pn * 256, shm, epi, wv, pre, nr, nc); } }
    GSYNC();
    prep_phase(p, wv, l, shm);
    if (l == 1) conv_phase(p, wv, 1, shm, CV_IN + CV_OUT + CV_UP, CV_TOTAL, 0);
    GSYNC();
    {
      mix1_phase(p, wv, l, last, shm, bcw);
      GSYNC();
    }
    {
      mix2_phase(p, wv, l, last);
      GSYNC();
    }
    { const int nM = last ? 64 : 72;
      for (int i = blockIdx.x; i < nM * 8; i += G) { int pm, pn, qm = -1, qn = -1; tile_map(i, nM, 8, pm, pn); if (last) pm = (pm >> 3) * 9 + 1 + (pm & 7);
        if (i + G < nM * 8) { tile_map(i + G, nM, 8, qm, qn); if (last) qm = (qm >> 3) * 9 + 1 + (qm & 7); }
        const bool pre = i != (int)blockIdx.x; const int nr = qm < 0 ? -1 : qm * 256, nc = qn * 256;
        const int b = pm / 9; const bool isctx = (pm % 9) == 0;
        const int mr = l * 9 + (isctx ? 8 : b);
        EpiOut epi;
        if (l == 0) { epi.base = isctx ? p->ctx + (size_t)b * CTX * DM : p->x + (size_t)b * SEQ * DM; epi.base_row0 = isctx ? (long)b * RPB : (long)b * RPB + CTX; }
        else { epi.base = p->X; epi.base_row0 = 0; }
        epi.X = p->X; epi.gate = p->mod + (size_t)mr * NMOD + 2 * DM; epi.n2g = p->norm2_g + l * DM; epi.scl = p->mod + (size_t)mr * NMOD + 4 * DM;
        epi.H2 = (bf16_t*)p->RO; epi.ssq = (float*)(p->ctl + SSQ_WORD) + (size_t)l * NROWS;
        gemm_tile(p->H, DM, p->Wt_out, DM, DM, pm * 256, pn * 256, shm, epi, wv, pre, nr, nc); }
      if (l == 0) conv_phase(p, wv, 0, shm, CV_IN + CV_OUT, CV_TOTAL, (nM * 8) % G ? (nM * 8) % G : 0); }
    GSYNC();
    {
      const int nM = last ? 64 : 72;
      for (int i = blockIdx.x; i < nM * 44; i += G) { int pm, pn; tile_map(i, nM, 44, pm, pn); if (last) pm = (pm >> 3) * 9 + 1 + (pm & 7);
        const int mr = l * 9 + ((pm % 9) == 0 ? 8 : pm / 9);
        EpiUp epi{p->conv_w + (size_t)l * 3 * DFF, p->conv_b + (size_t)l * DFF, p->U, p->HA, p->HB, pm, pn, (const float*)(p->ctl + SSQ_WORD) + (size_t)l * NROWS, p->sW + (size_t)mr * (2 * DFF)};
        gemm_tile((const bf16_t*)p->RO, DM, p->Wt_up, DM, DM, pm * 256, pn * 256, shm, epi, wv); }
      GSYNC();
    }
    {
      fixup_phase(p, wv, l, last);
      GSYNC();
    }
    { const int nM = last ? 64 : 72;
      for (int i = blockIdx.x; i < nM * 8; i += G) { int pm, pn, qm = -1, qn = -1; tile_map(i, nM, 8, pm, pn, 4); if (last) pm = (pm >> 3) * 9 + 1 + (pm & 7);
        if (i + G < nM * 8) { tile_map(i + G, nM, 8, qm, qn, 4); if (last) qm = (qm >> 3) * 9 + 1 + (qm & 7); }
        const bool pre = i != (int)blockIdx.x; const int nr = qm < 0 ? -1 : qm * 256, nc = qn * 256;
        const int b = pm / 9; const bool isctx = (pm % 9) == 0;
        if (l == 0) {
          EpiOut epi; epi.base = p->X; epi.base_row0 = 0; epi.X = p->X; epi.gate = p->mod + (size_t)(isctx ? 8 : b) * NMOD + 5 * DM;
          epi.n2g = p->norm1_g + DM; epi.scl = p->mod + (size_t)(9 + (isctx ? 8 : b)) * NMOD + 1 * DM; epi.H2 = p->H; epi.ssq = (float*)(p->ctl + SSQ_WORD) + (size_t)2 * NROWS;
          gemm_tile(p->U, DFF, p->Wt_down, DFF, DFF, pm * 256, pn * 256, shm, epi, wv, pre, nr, nc);
        } else {
          EpiFinal epi; epi.X = p->X; epi.gate = p->mod + (size_t)(l * 9 + b) * NMOD + 5 * DM; epi.fg = p->final_norm_g;
          epi.out = p->out + ((size_t)b * SEQ + (size_t)(pm % 9 - 1) * 256) * DM; epi.fsq = (float*)(p->ctl + FSQ_WORD); epi.cnt = p->ctl + FCN_WORD + 64 * pm; epi.ctl = p->ctl;
          gemm_tile(p->U, DFF, p->Wt_down, DFF, DFF, pm * 256, pn * 256, shm, epi, wv, pre, nr, nc);
        } }
      if (l == 0) conv_phase(p, wv, 1, shm, 0, CV_IN + CV_OUT + CV_UP, (nM * 8) % G ? (nM * 8) % G : 0); }
    if (!last) GSYNC();
  }

__global__ void __launch_bounds__(NTHR) mega(Params pk) {
  extern __shared__ __attribute__((aligned(16))) char shm[];
  __shared__ uint4 xb_words;
  cg::grid_group grid = cg::this_grid();
  KP p = relaunder((KP)__builtin_amdgcn_kernarg_segment_ptr());
  const int wv = __builtin_amdgcn_readfirstlane((int)(threadIdx.x >> 6));
  if (threadIdx.x == 0) xb_words = make_uint4(0u, 0u, 0u, 0u);
  __syncthreads();
  const XcdBarrier xbar = xcd_barrier_post(p->ctl, (volatile LAS unsigned*)&xb_words);
#define GSYNC() xcd_barrier(xbar)
  layer_body<0>(p, wv, shm, grid, xbar, (volatile LAS unsigned*)&xb_words);
  layer_body<1>(p, wv, shm, grid, xbar, (volatile LAS unsigned*)&xb_words);
}

static inline size_t al256(size_t x) { return (x + 255) & ~(size_t)255; }
extern "C" void kernel_launch(void* const* d_in, const int* in_sizes, int n_in, void* d_out, int out_size, void* d_ws, size_t ws_size, hipStream_t stream) {
  static int grid_blocks = 0;
  if (!grid_blocks) {
    int dev = 0, cus = 0, per_cu = 0;
    hipGetDevice(&dev);
    hipDeviceGetAttribute(&cus, hipDeviceAttributeMultiprocessorCount, dev);
    if (hipFuncSetAttribute((const void*)mega, hipFuncAttributeMaxDynamicSharedMemorySize, SHM_BYTES) != hipSuccess) fprintf(stderr, "hipFuncSetAttribute failed\n");
    hipOccupancyMaxActiveBlocksPerMultiprocessor(&per_cu, mega, NTHR, SHM_BYTES);
    if (per_cu < 1) { fprintf(stderr, "occupancy query returned %d\n", per_cu); per_cu = 1; }
    if (per_cu > 1) per_cu = 1;
    grid_blocks = cus * per_cu;
  }
  Params p{};
  const float* const* in = (const float* const*)d_in;
  p.x = in[0]; p.c = in[1]; p.ctx = in[2]; p.c_ctx = in[3]; p.ada_w = in[4]; p.ada_b = in[5]; p.norm1_g = in[6]; p.w_in = in[7];
  p.q_norm_g = in[8]; p.k_norm_g = in[9]; p.ret_log_decay = in[10]; p.ret_norm_g = in[11]; p.gla_gate_up = in[12]; p.gla_gate_b = in[13];
  p.gla_norm_g = in[14]; p.w_out = in[15]; p.norm2_g = in[16]; p.w_up = in[17]; p.conv_w = in[18]; p.conv_b = in[19]; p.w_down = in[20]; p.final_norm_g = in[21];
  p.out = (float*)d_out;
  char* w = (char*)d_ws; size_t off = 0;
  auto take = [&](size_t bytes) { char* r = w + off; off = al256(off + bytes); return r; };
  p.Wt_in = (bf16_t*)take((size_t)ZLD * DM * 2);
  p.Wt_out = (bf16_t*)take((size_t)DM * DM * 2);
  p.Wt_up = (bf16_t*)take((size_t)2 * DFF * DM * 2);
  p.Wt_down = (bf16_t*)take((size_t)DM * DFF * 2);
  p.mod = (float*)take((size_t)2 * 9 * NMOD * 4);
  p.X = (float*)take((size_t)NROWS * DM * 4);
  p.H = (bf16_t*)take((size_t)NROWS * DM * 2);
  p.HA = (float*)take((size_t)72 * 2 * DFF * 4);
  p.HB = (float*)take((size_t)72 * 2 * DFF * 2 * 4);
  p.ctl = (unsigned*)take((size_t)CTL_WORDS * 4);
  p.sW = (float*)take((size_t)2 * 9 * 2 * DFF * 4);
  p.sWin = (float*)take((size_t)9 * ZLD * 4);
  p.Kc = (bf16_t*)take((size_t)NB * 2 * RPB * 128 * 2);
  p.Vc = (bf16_t*)take((size_t)NB * 2 * RPB * 128 * 2);
  const size_t roff = off;
  p.Z = (bf16_t*)take((size_t)NROWS * ZLD * 2);
  p.GQt = (bf16_t*)take((size_t)2 * NROWS * 256 * 2);
  p.GKt = (bf16_t*)take((size_t)2 * NROWS * 256 * 2);
  p.Eend = (float*)take((size_t)2 * (NROWS / 64) * 256 * 4);
  p.RO = (bf16_t*)take((size_t)2 * NROWS * 512 * 2);
  p.GO = (bf16_t*)take((size_t)2 * NROWS * 512 * 2);
  p.U = (bf16_t*)(w + roff);
  if (off > ws_size) { fprintf(stderr, "workspace too small: need %zu have %zu\n", off, ws_size); return; }
  if (hipMemsetAsync(p.ctl, 0, (size_t)CTL_WORDS * 4, stream) != hipSuccess) fprintf(stderr, "memset failed\n");
  void* args[] = {&p};
  hipError_t e = hipLaunchCooperativeKernel((void*)mega, dim3(grid_blocks), dim3(NTHR), args, SHM_BYTES, stream);
  if (e != hipSuccess) fprintf(stderr, "cooperative launch failed: %s (grid %d)\n", hipGetErrorString(e), grid_blocks);
}
```
